# Optimizing an MI355X kernel written in HIP

```python
import functools
import jax, jax.numpy as jnp
from jax import lax
import numpy as np

D_MODEL = 1024
BATCH = 16
SEQ = 256
DEPTH = 2
DEC_BATCH = 4
DEC_SEQ = 2048
PAST_LEN = 256

GRID_W = 64
HEAD_DIM = 64
WIDTH_A = D_MODEL // 2
N_HEADS_A = WIDTH_A // HEAD_DIM
WIN_R = 8
WIN_C = 16
WIDTH_B = D_MODEL // 4
N_GROUPS_B = 4
GROUP_B = WIDTH_B // N_GROUPS_B
WIDTH_C = D_MODEL // 4
POOL_WINDOWS = (2, 4, 8, 16)
GROUP_C = WIDTH_C // len(POOL_WINDOWS)
Q_BLOCK = 128
EPS = 1e-6
NEG_INF = -1e30
BASE_W = 4 * WIDTH_A + 2 * WIDTH_B + 2 * WIDTH_C
IN_WIDTH = BASE_W + 3 * D_MODEL
SPLIT_POINTS = (WIDTH_A, 2 * WIDTH_A, 3 * WIDTH_A, 4 * WIDTH_A,
                4 * WIDTH_A + WIDTH_B, 4 * WIDTH_A + 2 * WIDTH_B,
                4 * WIDTH_A + 2 * WIDTH_B + WIDTH_C, BASE_W,
                BASE_W + D_MODEL, BASE_W + 2 * D_MODEL)

kernel_name = 'hybrid_natten_fnet_pool_diffusion_step'


def _rmsnorm(x, g):
    xf = x.astype(jnp.float32)
    y = xf * lax.rsqrt(jnp.mean(xf * xf, axis=-1, keepdims=True) + EPS)
    return y.astype(x.dtype) * g


def _ada(cond, w_ada, b_ada):
    a = jax.nn.silu(cond) @ w_ada + b_ada
    return jnp.split(a, 3, axis=-1)


def _heads(t):
    b, l, _ = t.shape
    return t.reshape(b, l, N_HEADS_A, HEAD_DIM).transpose(0, 2, 1, 3)


def _ctx_attention(q, k, v):
    b, h, l, d = q.shape
    nb = l // Q_BLOCK
    qb = q.reshape(b, h, nb, Q_BLOCK, d).transpose(2, 0, 1, 3, 4)
    scale = HEAD_DIM ** -0.5

    def block(qi):
        s = jnp.einsum('bhqd,bhkd->bhqk', qi, k).astype(jnp.float32) * scale
        p = jax.nn.softmax(s, axis=-1).astype(v.dtype)
        return jnp.einsum('bhqk,bhkd->bhqd', p, v)

    o = lax.map(block, qb)
    return o.transpose(1, 0, 3, 2, 4).reshape(b, l, h * d)


def _na_attention(q, k, v, k_ctx, v_ctx, rpb):
    b, h, n, d = q.shape
    rows = n // GRID_W
    wr = min(WIN_R, rows)
    nw = wr * GRID_W
    kg = k.reshape(b, h, rows, GRID_W, d)
    vg = v.reshape(b, h, rows, GRID_W, d)
    q_rows = q.reshape(b, h, rows, GRID_W, d).transpose(2, 0, 1, 3, 4)
    row_start = jnp.clip(jnp.arange(rows) - wr // 2, 0, rows - wr)
    col = jnp.arange(GRID_W)
    col_start = jnp.clip(col - WIN_C // 2, 0, GRID_W - WIN_C)
    col_ok = (col[None, :] >= col_start[:, None]) & (col[None, :] < col_start[:, None] + WIN_C)
    win_mask = jnp.broadcast_to(col_ok[:, None, :], (GRID_W, wr, GRID_W)).reshape(GRID_W, nw)
    col_idx = jnp.clip(col[None, :] - col[:, None] + WIN_C - 1, 0, 2 * WIN_C - 2)
    scale = HEAD_DIM ** -0.5

    def row_block(args):
        qr, r = args
        rs = row_start[r]
        kw = lax.dynamic_slice_in_dim(kg, rs, wr, axis=2).reshape(b, h, nw, d)
        vw = lax.dynamic_slice_in_dim(vg, rs, wr, axis=2).reshape(b, h, nw, d)
        row_idx = rs + jnp.arange(wr) - r + WIN_R - 1
        bias = rpb[:, row_idx[None, :, None], col_idx[:, None, :]].reshape(h, GRID_W, nw)
        s_win = jnp.einsum('bhqd,bhkd->bhqk', qr, kw).astype(jnp.float32) * scale + bias.astype(jnp.float32)
        s_win = jnp.where(win_mask, s_win, NEG_INF)
        s_ctx = jnp.einsum('bhqd,bhcd->bhqc', qr, k_ctx).astype(jnp.float32) * scale
        p = jax.nn.softmax(jnp.concatenate([s_win, s_ctx], axis=-1), axis=-1).astype(v.dtype)
        return (jnp.einsum('bhqk,bhkd->bhqd', p[..., :nw], vw)
                + jnp.einsum('bhqc,bhcd->bhqd', p[..., nw:], v_ctx))

    o = lax.map(row_block, (q_rows, jnp.arange(rows)))
    return o.transpose(1, 0, 3, 2, 4).reshape(b, n, h * d)


def _fourier(u, w_fnet):
    b, l, _ = u.shape
    ug = u.reshape(b, l, N_GROUPS_B, GROUP_B).astype(jnp.float32)
    f = jnp.fft.fft2(ug, axes=(1, 3), norm='ortho').real
    return f.reshape(b, l, WIDTH_B).astype(u.dtype) @ w_fnet


def _pool(u, w_pool, pool_scale):
    b, l, _ = u.shape
    uf = u.astype(jnp.float32)
    csum = jnp.concatenate([jnp.zeros((b, 1, WIDTH_C), jnp.float32), jnp.cumsum(uf, axis=1)], axis=1)
    t = jnp.arange(l)
    outs = []
    for gi, w in enumerate(POOL_WINDOWS):
        lo = jnp.clip(t - w // 2, 0, l)
        hi = jnp.clip(t + w // 2, 0, l)
        cg = csum[:, :, gi * GROUP_C:(gi + 1) * GROUP_C]
        mean = (cg[:, hi] - cg[:, lo]) / (hi - lo).astype(jnp.float32)[None, :, None]
        outs.append(mean - uf[:, :, gi * GROUP_C:(gi + 1) * GROUP_C])
    dlt = jnp.stack(outs, axis=2).astype(u.dtype)
    y = jnp.einsum('blgc,gce->blge', dlt, w_pool).reshape(b, l, WIDTH_C)
    return y * pool_scale


def _layer(x, shift, scale, gate, lp, attend):
    (norm_g, w_in, q_g, k_g, w_fnet, w_pool, pool_scale, p_a, p_b, p_c, w_o) = lp
    h = _rmsnorm(x, norm_g) * (1 + scale) + shift
    q, k, v, z_a, u_b, z_b, u_c, z_c, g_a, g_b, g_c = jnp.split(h @ w_in, SPLIT_POINTS, axis=-1)
    q = _rmsnorm(_heads(q), q_g)
    k = _rmsnorm(_heads(k), k_g)
    v = _heads(v)
    y_a = attend(q, k, v)
    y_b = _fourier(u_b, w_fnet)
    y_c = _pool(u_c, w_pool, pool_scale)
    merged = (jax.nn.sigmoid(g_a) * ((jax.nn.silu(z_a) * y_a) @ p_a)
              + jax.nn.sigmoid(g_b) * ((jax.nn.silu(z_b) * y_b) @ p_b)
              + jax.nn.sigmoid(g_c) * ((jax.nn.silu(z_c) * y_c) @ p_c))
    return x + gate * (merged @ w_o), k, v


def setup_inputs(seed: int = 0) -> dict:
    key = jax.random.key(seed)
    ks = jax.random.split(key, 20)

    def nrm(k, shape, s):
        return jax.random.normal(k, shape, jnp.float32) * s

    return {
        'x_prompt': nrm(ks[0], (BATCH, SEQ, D_MODEL), 1.0),
        'x_sample': nrm(ks[1], (DEC_BATCH, DEC_SEQ, D_MODEL), 1.0),
        'cache_k': nrm(ks[2], (DEC_BATCH, DEPTH, N_HEADS_A, PAST_LEN, HEAD_DIM), 1.0),
        'cache_v': nrm(ks[3], (DEC_BATCH, DEPTH, N_HEADS_A, PAST_LEN, HEAD_DIM), 1.0),
        'c': nrm(ks[4], (DEC_BATCH, D_MODEL), 1.0),
        'c_ctx': nrm(ks[5], (D_MODEL,), 1.0),
        'norm_g': 1.0 + nrm(ks[6], (DEPTH, D_MODEL), 0.02),
        'w_ada': nrm(ks[7], (DEPTH, D_MODEL, 3 * D_MODEL), 0.5 * D_MODEL ** -0.5),
        'b_ada': nrm(ks[8], (DEPTH, 3 * D_MODEL), 0.01),
        'w_in': nrm(ks[9], (DEPTH, D_MODEL, IN_WIDTH), D_MODEL ** -0.5),
        'q_norm_g': 1.0 + nrm(ks[10], (DEPTH, HEAD_DIM), 0.02),
        'k_norm_g': 1.0 + nrm(ks[11], (DEPTH, HEAD_DIM), 0.02),
        'rpb': nrm(ks[12], (DEPTH, N_HEADS_A, 2 * WIN_R - 1, 2 * WIN_C - 1), 0.1),
        'w_fnet': nrm(ks[13], (DEPTH, WIDTH_B, WIDTH_B), WIDTH_B ** -0.5),
        'w_pool': nrm(ks[14], (DEPTH, len(POOL_WINDOWS), GROUP_C, GROUP_C), GROUP_C ** -0.5),
        'pool_scale': 1.0 + nrm(ks[15], (DEPTH, WIDTH_C), 0.02),
        'p_a': nrm(ks[16], (DEPTH, WIDTH_A, D_MODEL), WIDTH_A ** -0.5),
        'p_b': nrm(ks[17], (DEPTH, WIDTH_B, D_MODEL), WIDTH_B ** -0.5),
        'p_c': nrm(ks[18], (DEPTH, WIDTH_C, D_MODEL), WIDTH_C ** -0.5),
        'w_o': nrm(ks[19], (DEPTH, D_MODEL, D_MODEL), D_MODEL ** -0.5),
    }


def reference(x_prompt, x_sample, cache_k, cache_v, c, c_ctx, norm_g, w_ada, b_ada, w_in,
              q_norm_g, k_norm_g, rpb, w_fnet, w_pool, pool_scale, p_a, p_b, p_c, w_o):
    xp = x_prompt
    xs = x_sample
    new_k = []
    new_v = []
    for l in range(DEPTH):
        lp = (norm_g[l], w_in[l], q_norm_g[l], k_norm_g[l], w_fnet[l], w_pool[l],
              pool_scale[l], p_a[l], p_b[l], p_c[l], w_o[l])
        shift, scale, gate = _ada(c_ctx, w_ada[l], b_ada[l])
        xp, k_l, v_l = _layer(xp, shift, scale, gate, lp, _ctx_attention)
        new_k.append(k_l)
        new_v.append(v_l)
        shift, scale, gate = _ada(c[:, None, :], w_ada[l], b_ada[l])
        attend = functools.partial(_na_attention, k_ctx=cache_k[:, l], v_ctx=cache_v[:, l], rpb=rpb[l])
        xs, _, _ = _layer(xs, shift, scale, gate, lp, attend)
    return (xp, xs, jnp.stack(new_k, axis=1), jnp.stack(new_v, axis=1))
```

```cpp
#include <hip/hip_runtime.h>
#include <hip/hip_cooperative_groups.h>
#include <cstdio>
#include <cstdint>
namespace cg = cooperative_groups;

#ifndef MK_SINGLE
#define MK_SINGLE 1
#endif

#define LAS __attribute__((address_space(3)))
typedef unsigned short bf16_t;
typedef short bf16x8 __attribute__((ext_vector_type(8)));
typedef short s16x4 __attribute__((ext_vector_type(4)));
typedef float f32x2 __attribute__((ext_vector_type(2)));
typedef float f32x4 __attribute__((ext_vector_type(4)));
typedef float f32x16 __attribute__((ext_vector_type(16)));
typedef unsigned u32x2 __attribute__((ext_vector_type(2)));
typedef unsigned u32x4 __attribute__((ext_vector_type(4)));
typedef __bf16 bf16x2_t __attribute__((ext_vector_type(2)));

#define DI __device__ __forceinline__
#define LAUNDER() asm volatile("" : "+v"(fr), "+v"(fq), "+s"(wr), "+s"(wc))

DI int otid() { int t = threadIdx.x; asm volatile("" : "+v"(t)); return t; }
DI unsigned pk2(float lo, float hi) { f32x2 v = {lo, hi}; bf16x2_t b = __builtin_convertvector(v, bf16x2_t); return __builtin_bit_cast(unsigned, b); }
DI float bflo(unsigned w) { return __uint_as_float(w << 16); }
DI float bfhi(unsigned w) { return __uint_as_float(w & 0xffff0000u); }
DI u32x4 pk8(const float* v) { u32x4 w; w.x = pk2(v[0], v[1]); w.y = pk2(v[2], v[3]); w.z = pk2(v[4], v[5]); w.w = pk2(v[6], v[7]); return w; }
DI float sigmoidf_(float v) { return __builtin_amdgcn_rcpf(1.0f + __builtin_amdgcn_exp2f(-1.4426950408889634f * v)); }

constexpr int T = 12288, TP = 4096, TS = 8192, DM = 1024, INW = 6144;
constexpr float LOG2E = 1.4426950408889634f;
constexpr float EPS = 1e-6f;

constexpr size_t WS_ADAP = 0;
constexpr size_t WS_ADA  = WS_ADAP + 16ull * 2 * 5 * 3072 * 4;
constexpr size_t WS_MCS  = WS_ADA + 2ull * 5 * 3072 * 4;
constexpr size_t WS_WIN  = WS_MCS + 2ull * 2 * 256 * 256 * 4;
constexpr size_t WIN_L   = 6400ull * 1024 * 2;
constexpr size_t WS_PT   = WS_WIN + 2 * WIN_L;
constexpr size_t WS_WO   = WS_PT + 2ull * 1024 * 1024 * 2;
constexpr size_t WS_DS   = WS_WO + 2ull * 1024 * 1024 * 2;
constexpr size_t WS_DP   = WS_DS + 2048ull * 4096 * 2;
constexpr size_t WS_CK   = WS_DP + 256ull * 4096 * 2;
constexpr size_t WS_CV   = WS_CK + 4ull * 2 * 8 * 256 * 64 * 2;
constexpr size_t WS_XH   = WS_CV + 4ull * 2 * 8 * 256 * 64 * 2;
constexpr size_t YBP_BYTES = 8ull * 8192 * 256 * 2 + 4096ull * 256 * 2;
constexpr size_t WS_QB   = WS_XH + YBP_BYTES;
constexpr size_t WS_KB   = WS_QB + (size_t)T * 512 * 2;
constexpr size_t WS_VB   = WS_KB + (size_t)T * 512 * 2;
constexpr size_t WS_VTS  = WS_VB + (size_t)T * 512 * 2;
constexpr size_t WS_VTP  = WS_VTS + 2ull * 256 * 8192 * 2;
constexpr size_t WS_G    = WS_VTP + 256ull * 8192 * 2;
constexpr size_t WS_UC   = WS_G + (size_t)T * 1024 * 2;
constexpr size_t WS_SG   = WS_UC + (size_t)T * 256 * 2;
constexpr size_t WS_BAR  = WS_SG + 3ull * T * 1024 * 2;
constexpr size_t WS_RSS  = WS_BAR + 16384;
constexpr size_t WS_SW   = WS_RSS + (size_t)T * 4;
constexpr size_t WS_Y1K  = WS_SW + 5ull * 6400 * 4;
constexpr size_t WS_END  = WS_Y1K + 4ull * 256 * 4;
constexpr size_t ZERO_BYTES = 16384 + (size_t)T * 4;
static_assert(WS_END <= 268435456ull, "workspace");

constexpr int LDS_RING = 131072;
constexpr int LDS_BYTES = LDS_RING + 16;

namespace pg8 {
constexpr int BM = 256, BK = 64, HALF = 128, HTB = HALF * BK * 2;
DI int lds_byte(int r, int c) { const int st = (r >> 4) * 2 + (c >> 5), rr = r & 15, cc = c & 31, ob = rr * 64 + cc * 2; return st * 1024 + (ob ^ (((ob >> 9) & 1) << 5)); }
DI void stage_rc(int b, int& R, int& C) { const int st = b / 1024, sb = b % 1024, swz = sb ^ (((sb >> 9) & 1) << 5); R = (st >> 1) * 16 + swz / 64; C = (st & 1) * 32 + (swz % 64) / 2; }
struct Unit { const char* a; const char* b; int k0, k1, k2, k3; };

struct NoHook { static constexpr bool ENABLED = false; DI void operator()(f32x4 (&)[2][2][4][2], const Unit&, int, int, int, int, int) const {} };
template <class Epi, class Sched, class Hook = NoHook>
DI void gemm_phase(LAS unsigned char* lds, const int pitchA, const int pitchB, const int nt, const Sched& S, const Epi& E, const Hook& H = Hook()) {
    const int tid = otid(), wid = __builtin_amdgcn_readfirstlane(tid >> 6), lane = tid & 63, wr = wid >> 2, wc = wid & 3, fr = lane & 15, fq = lane >> 4;
    unsigned voffA[2], voffB[2];
#pragma unroll
    for (int i = 0; i < 2; ++i) { int R, C; stage_rc(tid * 16 + i * 8192, R, C); voffA[i] = (unsigned)(R * pitchA + C) * 2u; voffB[i] = (unsigned)(R * pitchB + C) * 2u; }
    const size_t kstep = (size_t)(BK * 2);
    const size_t hstepA = (size_t)HALF * pitchA * 2, hstepB = (size_t)HALF * pitchB * 2;
    const unsigned ldsw = (unsigned)wid * 1024u;
    const int aoff = lds_byte(wr * 64 + fr, fq * 8), boff = lds_byte(wc * 32 + fr, fq * 8);
#define PG8_SA(b, h) (((b) * 2 + (h)) * HTB)
#define PG8_SB(b, h) ((4 + (b) * 2 + (h)) * HTB)
#define PG8_STAGE(bufoff, gbase, voff) do { _Pragma("unroll") for (int _i = 0; _i < 2; ++_i) \
        __builtin_amdgcn_global_load_lds((const unsigned*)((const char*)(gbase) + (voff)[_i]), (LAS unsigned*)(lds + (bufoff) + ldsw + _i * 8192), 16, 0, 0); } while (0)
#define PG8_LDA(dst, b, h) do { _Pragma("unroll") for (int m = 0; m < 4; ++m) _Pragma("unroll") for (int k = 0; k < 2; ++k) dst[m][k] = *(const LAS bf16x8*)(lds + PG8_SA(b, h) + aoff + m * 2048 + k * 1024); } while (0)
#define PG8_LDB(dst, b, h) do { _Pragma("unroll") for (int n = 0; n < 2; ++n) _Pragma("unroll") for (int k = 0; k < 2; ++k) dst[n][k] = *(const LAS bf16x8*)(lds + PG8_SB(b, h) + boff + n * 2048 + k * 1024); } while (0)
#define PG8_MMA(ai, bj, At, Bt) do { __builtin_amdgcn_s_setprio(1); _Pragma("unroll") for (int m = 0; m < 4; ++m) _Pragma("unroll") for (int n = 0; n < 2; ++n) _Pragma("unroll") for (int k = 0; k < 2; ++k) \
        acc[ai][bj][m][n] = __builtin_amdgcn_mfma_f32_16x16x32_bf16(Bt[n][k], At[m][k], acc[ai][bj][m][n], 0, 0, 0); __builtin_amdgcn_s_setprio(0); } while (0)
#define PG8_WAIT_V(n) asm volatile("s_waitcnt vmcnt(" #n ")" ::: "memory")
#define PG8_WAIT_L(n) asm volatile("s_waitcnt lgkmcnt(" #n ")" ::: "memory")
#define PG8_BAR __builtin_amdgcn_s_barrier()
#define PG8_SCHED __builtin_amdgcn_sched_barrier(0)
    Unit cur, nxt; int ui = 0;
    if (!S.next(0, cur)) return;
    f32x4 acc[2][2][4][2];
#pragma unroll
    for (int a = 0; a < 2; ++a)
#pragma unroll
        for (int b = 0; b < 2; ++b)
#pragma unroll
            for (int m = 0; m < 4; ++m)
#pragma unroll
                for (int n = 0; n < 2; ++n) acc[a][b][m][n] = (f32x4){0.f, 0.f, 0.f, 0.f};
    bf16x8 At[4][2], B0[2][2], B1[2][2];
    const char* cA = cur.a; const char* cB = cur.b;
    PG8_STAGE(PG8_SB(0, 0), cB, voffB); PG8_STAGE(PG8_SB(0, 1), cB + hstepB, voffB); PG8_STAGE(PG8_SA(0, 0), cA, voffA); PG8_STAGE(PG8_SA(0, 1), cA + hstepA, voffA);
    if (wr == 1) PG8_BAR;
    PG8_WAIT_V(2); PG8_BAR;
    PG8_STAGE(PG8_SB(1, 0), cB + kstep, voffB); PG8_STAGE(PG8_SA(1, 0), cA + kstep, voffA); PG8_STAGE(PG8_SB(1, 1), cB + hstepB + kstep, voffB);
    PG8_WAIT_V(6); PG8_BAR;
    for (;;) {
        const bool has_next = S.next(ui + 1, nxt);
        const char* nA = has_next ? nxt.a : cA; const char* nB = has_next ? nxt.b : cB;
        for (int t = 0; t < nt; t += 2) {
            const bool last = (t == nt - 2);
            if constexpr (Hook::ENABLED) { if (t == 8 || t == 12) { int le = lane; asm volatile("" : "+v"(le)); H(acc, cur, t, wr, wc, le & 15, le >> 4); } }
            const char* a1 = cA + (size_t)(t + 1) * kstep;
            const char* a2 = last ? nA : cA + (size_t)(t + 2) * kstep; const char* b2 = last ? nB : cB + (size_t)(t + 2) * kstep;
            const char* a3 = a2 + kstep; const char* b3 = b2 + kstep;
            PG8_LDB(B0, 0, 0); PG8_LDB(B1, 0, 1); PG8_SCHED; PG8_LDA(At, 0, 0); PG8_STAGE(PG8_SA(1, 1), a1 + hstepA, voffA);
            PG8_WAIT_V(8); PG8_WAIT_L(0); PG8_BAR; PG8_MMA(0, 0, At, B0); PG8_MMA(0, 1, At, B1); PG8_BAR; PG8_SCHED;
            PG8_LDA(At, 0, 1); PG8_STAGE(PG8_SB(0, 0), b2, voffB); PG8_STAGE(PG8_SB(0, 1), b2 + hstepB, voffB); PG8_STAGE(PG8_SA(0, 0), a2, voffA);
            PG8_WAIT_V(8); PG8_WAIT_L(0); PG8_BAR; PG8_MMA(1, 0, At, B0); PG8_MMA(1, 1, At, B1); PG8_BAR; PG8_SCHED;
            PG8_LDB(B0, 1, 0); PG8_LDB(B1, 1, 1); PG8_SCHED; PG8_LDA(At, 1, 0); PG8_STAGE(PG8_SA(0, 1), a2 + hstepA, voffA);
            PG8_WAIT_V(8); PG8_WAIT_L(0); PG8_BAR; PG8_MMA(0, 0, At, B0); PG8_MMA(0, 1, At, B1); PG8_BAR; PG8_SCHED;
            PG8_LDA(At, 1, 1); PG8_STAGE(PG8_SB(1, 0), b3, voffB); PG8_STAGE(PG8_SB(1, 1), b3 + hstepB, voffB); PG8_STAGE(PG8_SA(1, 0), a3, voffA);
            PG8_WAIT_V(8); PG8_WAIT_L(0); PG8_BAR; PG8_MMA(1, 0, At, B0); PG8_MMA(1, 1, At, B1); PG8_BAR; PG8_SCHED;
        }
        if (wr == 0) PG8_BAR;
        { int le = lane; asm volatile("" : "+v"(le)); E(acc, cur, wr, wc, le & 15, le >> 4); }
        if (!has_next) break;
#pragma unroll
        for (int a = 0; a < 2; ++a)
#pragma unroll
            for (int b = 0; b < 2; ++b)
#pragma unroll
                for (int m = 0; m < 4; ++m)
#pragma unroll
                    for (int n = 0; n < 2; ++n) acc[a][b][m][n] = (f32x4){0.f, 0.f, 0.f, 0.f};
        cur = nxt; cA = nA; cB = nB; ++ui;
        if (wr == 1) PG8_BAR;
    }
    PG8_WAIT_V(0);
    PG8_BAR;
#undef PG8_SA
#undef PG8_SB
#undef PG8_STAGE
#undef PG8_LDA
#undef PG8_LDB
#undef PG8_MMA
#undef PG8_WAIT_V
#undef PG8_WAIT_L
#undef PG8_BAR
#undef PG8_SCHED
}
}
using pg8::Unit;

#define XB_TMO      128
#define XB_XCNT(j)  (256  + 64 * (j))
#define XB_XSUB(j)  (1280 + 64 * (j))
#define XB_XGEN(j)  (2304 + 64 * (j))
#define XB_TOP      3328
#define XB_TOPGEN   3392
#define XCD_BAR_WORDS 3456
#define XB_SPIN_CAP (1u << 20)
DI unsigned xb_ld(unsigned* p)              { return __hip_atomic_load(p, __ATOMIC_RELAXED, __HIP_MEMORY_SCOPE_AGENT); }
DI unsigned xb_add(unsigned* p, unsigned v) { return __hip_atomic_fetch_add(p, v, __ATOMIC_RELAXED, __HIP_MEMORY_SCOPE_AGENT); }
DI unsigned xb_xcc_id() { return (unsigned)__builtin_amdgcn_s_getreg((3 << 11) | 20) & 0xFu; }
#define XB_SPIN(cond, bar) do { unsigned _sp = 0; while (cond) { __builtin_amdgcn_s_sleep(1); \
    if ((++_sp & 255u) == 0u) { if (xb_ld(&(bar)[XB_TMO])) break; if (_sp > XB_SPIN_CAP) { atomicAdd(&(bar)[XB_TMO], 1u); break; } } } } while (0)
struct XcdBarrier { unsigned* bar; unsigned x; volatile LAS unsigned* st; };
DI XcdBarrier xcd_barrier_post(unsigned* bar, volatile LAS unsigned* st) {
    XcdBarrier b; b.bar = bar; b.x = xb_xcc_id(); b.st = st;
    if (threadIdx.x == 0) (void)xb_add(&bar[XB_XCNT(b.x)], 1u);
    return b;
}
DI void xcd_barrier_complete(unsigned* bar, unsigned x, unsigned& nloc, unsigned& nx) {
    const unsigned G = gridDim.x * gridDim.y * gridDim.z;
    unsigned sum, cnt, mine, sp = 0u;
    for (;;) {
        sum = 0u; cnt = 0u; mine = 0u;
#pragma unroll
        for (unsigned j = 0; j < 16; ++j) { const unsigned c = xb_ld(&bar[XB_XCNT(j)]); sum += c; cnt += (c > 0u) ? 1u : 0u; mine = (j == x) ? c : mine; }
        if (sum == G) break;
        __builtin_amdgcn_s_sleep(1);
        if ((++sp & 255u) == 0u) { if (xb_ld(&bar[XB_TMO])) break; if (sp > XB_SPIN_CAP) { atomicAdd(&bar[XB_TMO], 1u); break; } }
    }
    nloc = mine > 0u ? mine : 1u; nx = cnt > 0u ? cnt : 1u;
}
DI void xcd_barrier(const XcdBarrier& b) {
    asm volatile("s_waitcnt vmcnt(0)" ::: "memory");
    __syncthreads();
    if (threadIdx.x == 0) {
        unsigned* bar = b.bar;
        __builtin_amdgcn_s_waitcnt(0);
        unsigned nloc = b.st[0], nx = b.st[1];
        if (nloc == 0u) { xcd_barrier_complete(bar, b.x, nloc, nx); b.st[0] = nloc; b.st[1] = nx; }
        const unsigned old = xb_add(&bar[XB_XSUB(b.x)], 1u);
        const unsigned gen = old / nloc;
        if (old + 1u == (gen + 1u) * nloc) {
            __builtin_amdgcn_fence(__ATOMIC_RELEASE, "agent");
            asm volatile("s_waitcnt vmcnt(0)" ::: "memory");
            const unsigned og = xb_add(&bar[XB_TOP], 1u);
            const unsigned tg = og / nx;
            if (og + 1u == (tg + 1u) * nx) xb_add(&bar[XB_TOPGEN], 1u);
            else XB_SPIN(xb_ld(&bar[XB_TOPGEN]) == tg, bar);
            __builtin_amdgcn_fence(__ATOMIC_ACQUIRE, "agent");
            xb_add(&bar[XB_XGEN(b.x)], 1u);
            asm volatile("s_waitcnt vmcnt(0)" ::: "memory");
        } else {
            XB_SPIN(xb_ld(&bar[XB_XGEN(b.x)]) == gen, bar);
            __builtin_amdgcn_fence(__ATOMIC_ACQUIRE, "agent");
            asm volatile("s_waitcnt vmcnt(0)" ::: "memory");
        }
    }
    __syncthreads();
}

struct Args {
    const float* x_prompt; const float* x_sample; const float* cache_k; const float* cache_v; const float* c; const float* c_ctx;
    const float* norm_g; const float* w_ada; const float* b_ada; const float* w_in; const float* q_g; const float* k_g; const float* rpb;
    const float* w_fnet; const float* w_pool; const float* pool_scale; const float* p_a; const float* p_b; const float* p_c; const float* w_o;
    float* out; unsigned char* ws; int ph_lo, ph_hi;
};

typedef const __attribute__((address_space(4))) Args* KArgP;
DI Args load_args(KArgP p) {
    Args a;
    a.x_prompt = p->x_prompt; a.x_sample = p->x_sample; a.cache_k = p->cache_k; a.cache_v = p->cache_v; a.c = p->c; a.c_ctx = p->c_ctx;
    a.norm_g = p->norm_g; a.w_ada = p->w_ada; a.b_ada = p->b_ada; a.w_in = p->w_in; a.q_g = p->q_g; a.k_g = p->k_g; a.rpb = p->rpb;
    a.w_fnet = p->w_fnet; a.w_pool = p->w_pool; a.pool_scale = p->pool_scale; a.p_a = p->p_a; a.p_b = p->p_b; a.p_c = p->p_c; a.w_o = p->w_o;
    a.out = p->out; a.ws = p->ws; a.ph_lo = p->ph_lo; a.ph_hi = p->ph_hi;
    return a;
}

DI void ada_task(const Args& A, int task, int lane, bool direct) {
    float* adap = (float*)(A.ws + WS_ADAP);
    {
        const int ng = task % 48, kc = (task / 48) & 15, l = task / 768;
        const int k = kc * 64 + lane;
        float sv[5];
        { const float v = A.c_ctx[k]; sv[0] = v * sigmoidf_(v); }
#pragma unroll
        for (int j = 1; j < 5; ++j) { const float v = A.c[(j - 1) * 1024 + k]; sv[j] = v * sigmoidf_(v); }
        float acc[5] = {0.f, 0.f, 0.f, 0.f, 0.f};
        const float* wp = A.w_ada + ((size_t)l * 1024 + kc * 64) * 3072 + ng * 64 + lane;
#pragma unroll 16
        for (int kk = 0; kk < 64; ++kk) {
            const float w = __builtin_nontemporal_load(wp + (size_t)kk * 3072);
#pragma unroll
            for (int j = 0; j < 5; ++j) acc[j] += __shfl(sv[j], kk) * w;
        }
#pragma unroll
        for (int j = 0; j < 5; ++j) {
            if (direct) atomicAdd((float*)(A.ws + WS_ADA) + (size_t)(l * 5 + j) * 3072 + ng * 64 + lane, acc[j] + (kc == 0 ? A.b_ada[l * 3072 + ng * 64 + lane] : 0.f));
            else adap[((size_t)(kc * 2 + l) * 5 + j) * 3072 + ng * 64 + lane] = acc[j];
        }
    }
}

DI int prow(int L) { return (L & ~31) | (16 * ((L >> 2) & 1) + 4 * ((L >> 3) & 3) + (L & 3)); }
DI int pcol(int p) { return (p & ~31) | (8 * ((p >> 2) & 3) + 4 * ((p >> 4) & 1) + (p & 3)); }
DI int win_row(int n) {
    if (n < 1536) { const int pn = n >> 8, l = n & 255, wc = l >> 6, bj = (l >> 5) & 1, o = l & 31; return pn * 256 + 128 * bj + 32 * wc + o; }
    if (n < 2048) return n;
    if (n < 2304) return -1;
    if (n < 2560) return 2048 + (n - 2304);
    if (n < 2816) return -1;
    if (n < 3072) return 2560 + (n - 2816);
    return 2816 + (n - 3072);
}
template <bool WIN>
DI void transpose_task(const float* src, int K, int N, bf16_t* dst, int dp, int coloff, int wt, int lane) {
    const int nch = N >> 6; const int n = (wt % nch) * 64 + lane, kb = wt / nch;
    const int row0 = WIN ? win_row(n) : n;
    if (row0 < 0) return;
    const int row = prow(row0);
    const float* sp = src + (size_t)(kb * 64) * N + n;
    bf16_t* dq = dst + (size_t)row * dp + coloff + kb * 64;
#pragma unroll 4
    for (int k8 = 0; k8 < 8; ++k8) {
        float v[8];
#pragma unroll
        for (int i = 0; i < 8; ++i) v[i] = __builtin_nontemporal_load(sp + (size_t)(k8 * 8 + i) * N);
        *(u32x4*)(dq + k8 * 8) = pk8(v);
    }
}

DI void fold_pool_task(const Args& A, int task, int lane, LAS float* wl) {
    {
        const int k8 = task & 127, g = (task >> 7) & 3, l = task >> 9;
        const float* wi = A.w_in + (size_t)l * 1024 * INW + (size_t)(k8 * 8) * INW + 2560 + g * 64;
        const float* wp = A.w_pool + ((size_t)(l * 4 + g) * 64) * 64 + lane;
        float acc[8] = {0.f, 0.f, 0.f, 0.f, 0.f, 0.f, 0.f, 0.f};
        {
            float rw[8];
#pragma unroll
            for (int i = 0; i < 8; ++i) rw[i] = wi[(size_t)i * INW + lane];
#pragma unroll
            for (int i = 0; i < 8; ++i) wl[i * 64 + lane] = rw[i];
            asm volatile("" ::: "memory");
        }
#pragma unroll 16
        for (int cc = 0; cc < 64; ++cc) {
            const float p = wp[cc * 64];
#pragma unroll
            for (int i = 0; i < 8; ++i) acc[i] += wl[i * 64 + cc] * p;
        }
        asm volatile("" ::: "memory");
        const float sc = A.pool_scale[l * 256 + g * 64 + lane];
#pragma unroll
        for (int i = 0; i < 8; ++i) acc[i] *= sc;
        bf16_t* dst = (bf16_t*)(A.ws + WS_WIN + (size_t)l * WIN_L) + (size_t)(2304 + prow(g * 64 + lane)) * 1024 + k8 * 8;
        *(u32x4*)dst = pk8(acc);
    }
}

DI void mcs_task(const Args& A, int task, int lane, const LAS f32x2* tbl) {
    float* M = (float*)(A.ws + WS_MCS);
    {
        const int eg = task & 3, m = (task >> 2) & 255, l = task >> 10;
        const int g = m >> 6, n2 = m & 63, e = eg * 64 + lane;
        const float* wf = A.w_fnet + ((size_t)l * 256 + g * 64) * 256 + e;
        float ac = 0.f, as = 0.f;
#pragma unroll 8
        for (int k2 = 0; k2 < 64; ++k2) {
            const f32x2 cs_ = tbl[((n2 * k2) & 63) * 32];
            const float w = wf[(size_t)k2 * 256];
            ac += cs_.x * w; as += cs_.y * w;
        }
        M[((size_t)(l * 2 + 0) * 256 + m) * 256 + e] = ac;
        M[((size_t)(l * 2 + 1) * 256 + m) * 256 + e] = as;
    }
}

DI void dft_task(const Args& A, int task, const LAS f32x2* tbl) {
    bf16_t* DS = (bf16_t*)(A.ws + WS_DS); bf16_t* DP = (bf16_t*)(A.ws + WS_DP);
    const float ss = 1.0f / sqrtf(2048.0f * 64.0f), sp = 1.0f / 128.0f;
    {
        float cv[8], sv[8];
        if (task < 1024 * 256) {
            const int k1 = task >> 8, n0 = (task & 255) * 8;
#pragma unroll
            for (int i = 0; i < 8; ++i) { const f32x2 cs_ = tbl[(k1 * (n0 + i)) & 2047]; cv[i] = cs_.x * ss; sv[i] = -cs_.y * ss; }
            *(u32x4*)(DS + ((size_t)((n0 >> 9) * 1024 + k1)) * 512 + (n0 & 511)) = pk8(cv); *(u32x4*)(DS + ((size_t)((4 + (n0 >> 9)) * 1024 + k1)) * 512 + (n0 & 511)) = pk8(sv);
        } else {
            const int t2 = task - 1024 * 256; const int k1 = t2 >> 5, n0 = (t2 & 31) * 8;
#pragma unroll
            for (int i = 0; i < 8; ++i) { const f32x2 cs_ = tbl[((k1 * (n0 + i)) & 255) * 8]; cv[i] = cs_.x * sp; sv[i] = -cs_.y * sp; }
            *(u32x4*)(DP + (size_t)k1 * 512 + n0) = pk8(cv); *(u32x4*)(DP + (size_t)k1 * 512 + 256 + n0) = pk8(sv);
        }
    }
}

DI void cache_task(const Args& A, int task) {
    bf16_t* CK = (bf16_t*)(A.ws + WS_CK); bf16_t* CV = (bf16_t*)(A.ws + WS_CV);
    {
        const int which = task >> 17, i8 = (task & 131071) * 8;
        const float* s = (which ? A.cache_v : A.cache_k) + i8;
        const f32x4 a = __builtin_nontemporal_load((const f32x4*)s), b = __builtin_nontemporal_load((const f32x4*)(s + 4));
        u32x4 w; w.x = pk2(a[0], a[1]); w.y = pk2(a[2], a[3]); w.z = pk2(b[0], b[1]); w.w = pk2(b[2], b[3]);
        *(u32x4*)((which ? CV : CK) + i8) = w;
    }
}

DI void phase_a(const Args& A, bool direct, LAS unsigned char* lds) {
    const int tid = otid(), lane = tid & 63;
    LAS f32x2* tbl = (LAS f32x2*)lds;
    for (int i = tid; i < 2048; i += blockDim.x) { const float a = (float)i * (1.0f / 1024.0f); tbl[i] = (f32x2){cospif(a), sinpif(a)}; }
    __syncthreads();
    LAS float* wl = (LAS float*)(lds + 16384 + (tid >> 6) * 2048);
    const int gw = __builtin_amdgcn_readfirstlane((blockIdx.x * blockDim.x + tid) >> 6), GW = (gridDim.x * blockDim.x) >> 6;
    constexpr int N_ADA = 1536, N_FP = 1024, N_MCS = 2048, N_WIN = 2 * 1536, N_WO = 2 * 256, N_PA = 2 * 128, N_PB = 2 * 64, N_PC = 2 * 64, N_CACHE = 4096, N_DFT = 4224;
    constexpr int E0 = N_ADA, E1 = E0 + N_FP, E2 = E1 + N_MCS, E3 = E2 + N_WIN, E4 = E3 + N_WO, E5 = E4 + N_PA, E6 = E5 + N_PB, E7 = E6 + N_PC, E8 = E7 + N_CACHE, E9 = E8 + N_DFT;
    for (int id = gw; id < E9; id += GW) {
        if (id < E0) ada_task(A, id, lane, direct);
        else if (id < E1) fold_pool_task(A, id - E0, lane, wl);
        else if (id < E2) mcs_task(A, id - E1, lane, tbl);
        else if (id < E3) { const int w = id - E2, l = w / 1536; transpose_task<true>(A.w_in + (size_t)l * 1024 * INW, 1024, INW, (bf16_t*)(A.ws + WS_WIN + (size_t)l * WIN_L), 1024, 0, w % 1536, lane); }
        else if (id < E4) { const int w = id - E3, l = w / 256; transpose_task<false>(A.w_o + (size_t)l * 1024 * 1024, 1024, 1024, (bf16_t*)(A.ws + WS_WO) + (size_t)l * 1024 * 1024, 1024, 0, w % 256, lane); }
        else if (id < E5) { const int w = id - E4, l = w / 128; transpose_task<false>(A.p_a + (size_t)l * 512 * 1024, 512, 1024, (bf16_t*)(A.ws + WS_PT) + (size_t)l * 1024 * 1024, 1024, 0, w % 128, lane); }
        else if (id < E6) { const int w = id - E5, l = w / 64; transpose_task<false>(A.p_b + (size_t)l * 256 * 1024, 256, 1024, (bf16_t*)(A.ws + WS_PT) + (size_t)l * 1024 * 1024, 1024, 512, w % 64, lane); }
        else if (id < E7) { const int w = id - E6, l = w / 64; transpose_task<false>(A.p_c + (size_t)l * 256 * 1024, 256, 1024, (bf16_t*)(A.ws + WS_PT) + (size_t)l * 1024 * 1024, 1024, 768, w % 64, lane); }
        else if (id < E8) cache_task(A, (id - E7) * 64 + lane);
        else dft_task(A, (id - E8) * 64 + lane, tbl);
    }
}

DI void phase_b(const Args& A, LAS unsigned char* lds, bool direct) {
    const int tid = otid(), lane = tid & 63;
    const int gt = blockIdx.x * blockDim.x + tid, GT = gridDim.x * blockDim.x;
    const int gw = __builtin_amdgcn_readfirstlane(gt >> 6), GW = GT >> 6;
    const float* adap = (const float*)(A.ws + WS_ADAP); float* ada = (float*)(A.ws + WS_ADA);
    if (!direct) for (int i = gt; i < 2 * 5 * 3072; i += GT) {
        const int n = i % 3072, l = i / (5 * 3072);
        float s = A.b_ada[l * 3072 + n];
#pragma unroll
        for (int kc = 0; kc < 16; ++kc) s += adap[(size_t)kc * (2 * 5 * 3072) + i];
        ada[i] = s;
    }
    const float* M = (const float*)(A.ws + WS_MCS);
    LAS float* wl = (LAS float*)(lds + (tid >> 6) * 8192);
    for (int task = gw; task < 2048; task += GW) {
        const int k8 = task & 127, eg = (task >> 7) & 3, s = (task >> 9) & 1, l = task >> 10;
        const float* wi = A.w_in + (size_t)l * 1024 * INW + (size_t)(k8 * 8) * INW + 2048;
        const float* mp = M + ((size_t)(l * 2 + s) * 256) * 256 + eg * 64 + lane;
        f32x4 rw[8];
#pragma unroll
        for (int i = 0; i < 8; ++i) rw[i] = *(const f32x4*)(wi + (size_t)i * INW + lane * 4);
#pragma unroll
        for (int i = 0; i < 8; ++i) *(LAS f32x4*)(wl + i * 256 + lane * 4) = rw[i];
        asm volatile("" ::: "memory");
        float acc[8] = {0.f, 0.f, 0.f, 0.f, 0.f, 0.f, 0.f, 0.f};
#pragma unroll 16
        for (int m = 0; m < 256; ++m) {
            const float mv = mp[(size_t)m * 256];
#pragma unroll
            for (int i = 0; i < 8; ++i) acc[i] += wl[i * 256 + m] * mv;
        }
        asm volatile("" ::: "memory");
        bf16_t* dst = (bf16_t*)(A.ws + WS_WIN + (size_t)l * WIN_L) + (size_t)(5888 + s * 256 + prow(eg * 64 + lane)) * 1024 + k8 * 8;
        *(u32x4*)dst = pk8(acc);
    }
}

DI const float* x_row(const Args& A, int l, int t) {
    if (l == 0) return t < TP ? A.x_prompt + (size_t)t * 1024 : A.x_sample + (size_t)(t - TP) * 1024;
    return A.out + (size_t)t * 1024;
}
DI int cond_of(int t) { return t < TP ? 0 : 1 + ((t - TP) >> 11); }

DI void sw_tasks(const Args& A, int gw, int GW, int lane) {
    const float* ada = (const float*)(A.ws + WS_ADA);
    {
        float sh[5][16];
#pragma unroll
        for (int j = 0; j < 5; ++j)
#pragma unroll
            for (int q = 0; q < 4; ++q) { const f32x4 v = *(const f32x4*)(ada + (size_t)(5 + j) * 3072 + lane * 16 + q * 4); sh[j][4 * q] = v[0]; sh[j][4 * q + 1] = v[1]; sh[j][4 * q + 2] = v[2]; sh[j][4 * q + 3] = v[3]; }
        const bf16_t* W1 = (const bf16_t*)(A.ws + WS_WIN + WIN_L); float* SW = (float*)(A.ws + WS_SW);
        for (int n = gw; n < 6400; n += GW) {
            const u32x4 w0 = *(const u32x4*)(W1 + (size_t)n * 1024 + lane * 16), w1 = *(const u32x4*)(W1 + (size_t)n * 1024 + lane * 16 + 8);
            const float wv[16] = {bflo(w0.x), bfhi(w0.x), bflo(w0.y), bfhi(w0.y), bflo(w0.z), bfhi(w0.z), bflo(w0.w), bfhi(w0.w), bflo(w1.x), bfhi(w1.x), bflo(w1.y), bfhi(w1.y), bflo(w1.z), bfhi(w1.z), bflo(w1.w), bfhi(w1.w)};
#pragma unroll
            for (int j = 0; j < 5; ++j) {
                float a = 0.f;
#pragma unroll
                for (int q = 0; q < 16; ++q) a += sh[j][q] * wv[q];
#pragma unroll
                for (int o = 32; o >= 1; o >>= 1) a += __shfl_xor(a, o);
                if (lane == 0) SW[j * 6400 + n] = a;
            }
        }
    }
}

DI void phase_norm(const Args& A, int l, bool do_sw) {
    const int tid = otid(), lane = tid & 63;
    const int gw = __builtin_amdgcn_readfirstlane((blockIdx.x * blockDim.x + tid) >> 6), GW = (gridDim.x * blockDim.x) >> 6;
    const float* ada = (const float*)(A.ws + WS_ADA);
    if (l == 0 && do_sw) sw_tasks(A, gw, GW, lane);
    bf16_t* XH = (bf16_t*)(A.ws + WS_XH);
    for (int t0 = gw; t0 < T; t0 += 6 * GW) {
        f32x4 v[6][4]; float ss[6];
#pragma unroll
        for (int q = 0; q < 6; ++q) {
            const int t = min(t0 + q * GW, T - 1);
            const float* xr = x_row(A, l, t);
#pragma unroll
            for (int i = 0; i < 4; ++i) v[q][i] = *(const f32x4*)(xr + i * 256 + lane * 4);
        }
#pragma unroll
        for (int q = 0; q < 6; ++q) {
            float a = 0.f;
#pragma unroll
            for (int i = 0; i < 4; ++i) a += v[q][i][0] * v[q][i][0] + v[q][i][1] * v[q][i][1] + v[q][i][2] * v[q][i][2] + v[q][i][3] * v[q][i][3];
#pragma unroll
            for (int o = 32; o >= 1; o >>= 1) a += __shfl_xor(a, o);
            ss[q] = rsqrtf(a * (1.0f / 1024.0f) + EPS);
        }
#pragma unroll
        for (int q = 0; q < 6; ++q) {
            const int t = t0 + q * GW;
            if (t < T) {
                const int j = cond_of(t);
                const float* sh = ada + (size_t)(l * 5 + j) * 3072; const float* sc = sh + 1024;
#pragma unroll
                for (int i = 0; i < 4; ++i) {
                    const int c0 = i * 256 + lane * 4;
                    const f32x4 g = *(const f32x4*)(A.norm_g + l * 1024 + c0), s1 = *(const f32x4*)(sc + c0), s0 = *(const f32x4*)(sh + c0);
                    float o[4];
#pragma unroll
                    for (int e = 0; e < 4; ++e) o[e] = v[q][i][e] * ss[q] * g[e] * (1.0f + s1[e]) + s0[e];
                    u32x2 w; w.x = pk2(o[0], o[1]); w.y = pk2(o[2], o[3]);
                    *(u32x2*)(XH + (size_t)t * 1024 + c0) = w;
                }
            }
        }
    }
}

constexpr size_t TILE1K = 256ull * 1024 * 2;
struct InSched {
    const char* XH; const char* W; int c, G;
    DI bool next(int i, Unit& u) const {
        int pm, pnn;
        if (G == 256) { const int xcd = c & 7, slot = c >> 3, j = i * 32 + slot; if (j >= 150) return false; pnn = j / 6; pm = xcd * 6 + j % 6; }
        else { const int L = i * G + c; if (L >= 1200) return false; pm = L % 48; pnn = L / 48; }
        if (pnn < 23) { u.a = XH + (size_t)pm * TILE1K; u.b = W + (size_t)pnn * TILE1K; u.k0 = 0; u.k1 = pm; u.k2 = pnn; u.k3 = 0; }
        else { u.a = W + (size_t)pnn * TILE1K; u.b = XH + (size_t)pm * TILE1K; u.k0 = 1; u.k1 = pnn - 23; u.k2 = pm; u.k3 = 0; }
        return true;
    }
};
struct EpiIn {
    int l; int fused; unsigned char* ws; float* outk; const float* qg; const float* kg;
    DI void operator()(f32x4 (&acc)[2][2][4][2], const Unit& u, int wr, int wc, int fr, int fq) const {
        LAUNDER();
        bf16_t* const QB = (bf16_t*)(ws + WS_QB); bf16_t* const Gb = (bf16_t*)(ws + WS_G); bf16_t* const UC = (bf16_t*)(ws + WS_UC); bf16_t* const SG = (bf16_t*)(ws + WS_SG);
        bf16_t* const VTS = (bf16_t*)(ws + WS_VTS); bf16_t* const VTP = (bf16_t*)(ws + WS_VTP); const float* const rss = (const float*)(ws + WS_RSS); const float* const sw = (const float*)(ws + WS_SW);
        if (u.k0 == 0) {
            const int pm = u.k1, pn = u.k2;
            if (fused) {
                const float* swp = sw + (size_t)cond_of(256 * pm) * 6400 + 256 * pn + 32 * wc + 4 * fq;
                f32x4 sw4[2][2];
#pragma unroll
                for (int bj = 0; bj < 2; ++bj)
#pragma unroll
                    for (int n = 0; n < 2; ++n) sw4[bj][n] = *(const f32x4*)(swp + 128 * bj + 16 * n);
#pragma unroll
                for (int ai = 0; ai < 2; ++ai)
#pragma unroll
                    for (int m = 0; m < 4; ++m) {
                        const float rs = rsqrtf(rss[256 * pm + 128 * ai + 64 * wr + 16 * m + fr] * (1.0f / 1024.0f) + EPS);
#pragma unroll
                        for (int bj = 0; bj < 2; ++bj)
#pragma unroll
                            for (int n = 0; n < 2; ++n) acc[ai][bj][m][n] = acc[ai][bj][m][n] * rs + sw4[bj][n];
                    }
            }
#define VAL(ai, bj, m, n) (acc[ai][bj][m][n])
            if (pn < 6) {
                const int kind = pn >> 1, head = (pn & 1) * 4 + wc;
                bf16_t* buf = QB + (size_t)kind * ((size_t)T * 512);
                float* ob = outk + (size_t)(kind - 1) * (16ull * 2 * 8 * 256 * 64);
                const float* gp = kind == 0 ? qg : kg;
                const float qs = kind == 0 ? 0.125f * LOG2E : 1.0f;
                f32x4 gv[2][2];
#pragma unroll
                for (int bj = 0; bj < 2; ++bj)
#pragma unroll
                    for (int n = 0; n < 2; ++n) gv[bj][n] = kind < 2 ? *(const f32x4*)(gp + l * 64 + 32 * bj + 8 * fq + 4 * n) * qs : (f32x4){1.f, 1.f, 1.f, 1.f};
#pragma unroll
                for (int ai = 0; ai < 2; ++ai)
#pragma unroll
                    for (int m = 0; m < 4; ++m) {
                        const int r = 128 * ai + 64 * wr + 16 * m + fr; const int t = 256 * pm + r;
                        float rstd = 1.0f;
                        if (kind < 2) {
                            float ss = 0.f;
#pragma unroll
                            for (int bj = 0; bj < 2; ++bj)
#pragma unroll
                                for (int n = 0; n < 2; ++n) { const f32x4 v = VAL(ai, bj, m, n); ss += v[0] * v[0] + v[1] * v[1] + v[2] * v[2] + v[3] * v[3]; }
                            ss += __shfl_xor(ss, 16); ss += __shfl_xor(ss, 32);
                            rstd = rsqrtf(ss * (1.0f / 64.0f) + EPS);
                        }
#pragma unroll
                        for (int bj = 0; bj < 2; ++bj) {
                            const int d0 = 32 * bj + 8 * fq;
                            const f32x4 v0 = VAL(ai, bj, m, 0) * rstd * gv[bj][0], v1 = VAL(ai, bj, m, 1) * rstd * gv[bj][1];
                            u32x4 w; w.x = pk2(v0[0], v0[1]); w.y = pk2(v0[2], v0[3]); w.z = pk2(v1[0], v1[1]); w.w = pk2(v1[2], v1[3]);
                            *(u32x4*)(buf + (size_t)t * 512 + head * 64 + d0) = w;
                            if (kind >= 1 && pm < 16) { float* op = ob + ((size_t)((pm * 2 + l) * 8 + head) * 256 + r) * 64 + d0; *(f32x4*)op = v0; *(f32x4*)(op + 4) = v1; }
                        }
                    }
            } else {
                bf16_t* base; int ld, mode;
                if (pn < 9) { base = Gb + (pn - 6) * 256; ld = 1024; mode = 1; }
                else if (pn == 9) { base = UC; ld = 256; mode = 0; }
                else if (pn == 10) { base = Gb + 768; ld = 1024; mode = 1; }
                else {
                    bf16_t* tb = SG + ((size_t)(((pn - 11) >> 2) * 48 + pm) * 4 + ((pn - 11) & 3)) * 65536 + (size_t)((wr * 4 + wc) * 16 * 64 + fq * 16 + fr) * 8;
#pragma unroll
                    for (int ai = 0; ai < 2; ++ai)
#pragma unroll
                        for (int m = 0; m < 4; ++m)
#pragma unroll
                            for (int bj = 0; bj < 2; ++bj) {
                                float o[8];
#pragma unroll
                                for (int n = 0; n < 2; ++n) {
                                    const f32x4 v = VAL(ai, bj, m, n);
#pragma unroll
                                    for (int e = 0; e < 4; ++e) o[4 * n + e] = sigmoidf_(v[e]);
                                }
                                *(u32x4*)(tb + (size_t)(((ai * 4 + m) * 2 + bj) * 64) * 8) = pk8(o);
                            }
                    return;
                }
#pragma unroll
                for (int ai = 0; ai < 2; ++ai)
#pragma unroll
                    for (int m = 0; m < 4; ++m) {
                        const int r = 128 * ai + 64 * wr + 16 * m + fr;
                        bf16_t* rowp = base + (size_t)(256 * pm + r) * ld + 32 * wc + 8 * fq;
#pragma unroll
                        for (int bj = 0; bj < 2; ++bj) {
                            float o[8];
#pragma unroll
                            for (int n = 0; n < 2; ++n) {
                                const f32x4 v = VAL(ai, bj, m, n);
#pragma unroll
                                for (int e = 0; e < 4; ++e) { const float s = sigmoidf_(v[e]); o[4 * n + e] = mode == 0 ? v[e] : v[e] * s; }
                            }
                            *(u32x4*)(rowp + 128 * bj) = pk8(o);
                        }
                    }
            }
#undef VAL
        } else {
            const int s = u.k1, pt = u.k2;
            bf16_t* base;
            if (pt < 16) base = VTP + (size_t)pt * 256 * 512 + s * 256;
            else { const int ts0 = 256 * (pt - 16), b = ts0 >> 11, n10 = ts0 & 2047; base = VTS + ((size_t)(b * 8 + s * 4 + (n10 >> 9)) * 256) * 512 + (n10 & 511); }
            f32x4 rs4[2][2];
#pragma unroll
            for (int bj = 0; bj < 2; ++bj)
#pragma unroll
                for (int n = 0; n < 2; ++n) {
                    rs4[bj][n] = (f32x4){1.f, 1.f, 1.f, 1.f};
                    if (fused) { const f32x4 q = *(const f32x4*)(rss + 256 * pt + 128 * bj + 32 * wc + 16 * n + 4 * fq);
                        rs4[bj][n] = (f32x4){rsqrtf(q[0] * (1.0f / 1024.0f) + EPS), rsqrtf(q[1] * (1.0f / 1024.0f) + EPS), rsqrtf(q[2] * (1.0f / 1024.0f) + EPS), rsqrtf(q[3] * (1.0f / 1024.0f) + EPS)}; }
                }
            const float* swp = sw + (size_t)cond_of(256 * pt) * 6400 + 5888 + 256 * s;
#pragma unroll
            for (int ai = 0; ai < 2; ++ai)
#pragma unroll
                for (int m = 0; m < 4; ++m) {
                    const int r = 128 * ai + 64 * wr + 16 * m + fr;
                    const float swr = fused ? swp[r] : 0.f;
                    bf16_t* rowp = base + (size_t)r * 512 + 32 * wc + 4 * fq;
#pragma unroll
                    for (int bj = 0; bj < 2; ++bj)
#pragma unroll
                        for (int n = 0; n < 2; ++n) {
                            const f32x4 v = fused ? acc[ai][bj][m][n] * rs4[bj][n] + swr : acc[ai][bj][m][n];
                            u32x2 w; w.x = pk2(v[0], v[1]); w.y = pk2(v[2], v[3]);
                            *(u32x2*)(rowp + 128 * bj + 16 * n) = w;
                        }
                }
        }
    }
};

struct FourSched {
    const char* DS; const char* DP; const char* VTS; const char* VTP; int c, G;
    DI bool next(int i, Unit& u) const {
        const int f = i * G + c; if (f >= 144) return false;
        if (f < 128) { const int b = f >> 5, pm = (f >> 3) & 3, kc = f & 7;
            u.a = DS + ((size_t)(kc * 1024 + pm * 256) * 512) * 2; u.b = VTS + ((size_t)(b * 8 + kc) * 256 * 512) * 2; u.k0 = 0; u.k1 = b; u.k2 = pm; u.k3 = kc; }
        else { const int b = f - 128; u.a = DP; u.b = VTP + (size_t)b * 256 * 512 * 2; u.k0 = 1; u.k1 = b; u.k2 = 0; u.k3 = 0; }
        return true;
    }
};
struct EpiFour {
    bf16_t* YS; bf16_t* YP;
    DI void operator()(const f32x4 (&acc)[2][2][4][2], const Unit& u, int wr, int wc, int fr, int fq) const {
        LAUNDER();
        bf16_t* base = u.k0 == 0 ? YS + ((size_t)u.k3 * 8192 + u.k1 * 2048 + u.k2 * 256) * 256 : YP + (size_t)u.k1 * 256 * 256;
#pragma unroll
        for (int ai = 0; ai < 2; ++ai)
#pragma unroll
            for (int m = 0; m < 4; ++m) {
                const int r = 128 * ai + 64 * wr + 16 * m + fr;
                bf16_t* rowp = base + (size_t)r * 256 + 32 * wc + 8 * fq;
#pragma unroll
                for (int bj = 0; bj < 2; ++bj) {
                    const f32x4 v0 = acc[ai][bj][m][0], v1 = acc[ai][bj][m][1];
                    u32x4 w; w.x = pk2(v0[0], v0[1]); w.y = pk2(v0[2], v0[3]); w.z = pk2(v1[0], v1[1]); w.w = pk2(v1[2], v1[3]);
                    *(u32x4*)(rowp + 128 * bj) = w;
                }
            }
    }
};

DI int crow(int i, int hf) { return (i & 3) + 8 * (i >> 2) + 4 * hf; }
DI s16x4 tr_read(const LAS unsigned char* p) { return __builtin_bit_cast(s16x4, __builtin_amdgcn_ds_read_tr16_b64_v4i16((LAS s16x4*)p)); }

constexpr int VROW = 144, PBUF = 64 * VROW, STG = 2 * PBUF;
constexpr int RPB_LDS = 15360;

DI void attn_wg(const Args& A, int l, int kind, int b, int h, int r4, LAS unsigned char* lds, int wid, int lane, int tid, int dry) {
    const bf16_t* QB = (const bf16_t*)(A.ws + WS_QB); const bf16_t* KB = (const bf16_t*)(A.ws + WS_KB); const bf16_t* VB = (const bf16_t*)(A.ws + WS_VB);
    const bf16_t* CK = (const bf16_t*)(A.ws + WS_CK); const bf16_t* CV = (const bf16_t*)(A.ws + WS_CV);
    bf16_t* Gb = (bf16_t*)(A.ws + WS_G);
    const LAS float* rpbL = (const LAS float*)lds + 64 + h * 465;
    LAS unsigned char* sb = lds + RPB_LDS;
    const int r = lane & 31, hf = lane >> 5;
    int qtok, npair, rs = 0, rsU = 0, grow = 0, hq = 0;
    if (kind == 0) {
        grow = r4 * 4 + (wid >> 1); hq = wid & 1; qtok = TP + b * 2048 + grow * 64 + hq * 32 + r;
        rs = min(max(grow - 4, 0), 24); rsU = min(max(r4 * 4 - 4, 0), 24);
        const int rsL = min(max(r4 * 4 + 3 - 4, 0), 24);
        npair = 4 + (rsL + 8 - rsU);
    } else { qtok = b * 256 + wid * 32 + r; npair = 4; }
    const int qc = hq * 32 + r, cs = min(max(qc - 8, 0), 48);
    bf16x8 qf[4];
#pragma unroll
    for (int s = 0; s < 4; ++s) qf[s] = *(const bf16x8*)(QB + (size_t)qtok * 512 + h * 64 + 16 * s + 8 * hf);
    f32x16 o0, o1;
#pragma unroll
    for (int i = 0; i < 16; ++i) { o0[i] = 0.f; o1[i] = 0.f; }
    float mrun = -1e30f, lrun = 0.f;
    auto pair_ptrs = [&](int pi, const bf16_t*& kp, const bf16_t*& vp, int& pitch) {
        if (kind == 0) {
            if (pi < 4) { const size_t off = ((size_t)((b * 2 + l) * 8 + h) * 256 + 64 * pi) * 64; kp = CK + off; vp = CV + off; pitch = 64; }
            else { const size_t off = (size_t)(TP + b * 2048 + (rsU + pi - 4) * 64) * 512 + h * 64; kp = KB + off; vp = VB + off; pitch = 512; }
        } else { const size_t off = (size_t)(b * 256 + 64 * pi) * 512 + h * 64; kp = KB + off; vp = VB + off; pitch = 512; }
    };
    const int lrow = tid >> 3, lc16 = tid & 7;
    const int ldst = lrow * VROW + lc16 * 16;
    u32x4 kR[3], vR[3];
#define ATT_LOAD(J, P) do { if ((P) < npair) { const bf16_t* kp_; const bf16_t* vp_; int pitch_; pair_ptrs((P), kp_, vp_, pitch_); \
        kR[J] = *(const u32x4*)(kp_ + (size_t)lrow * pitch_ + lc16 * 8); vR[J] = *(const u32x4*)(vp_ + (size_t)lrow * pitch_ + lc16 * 8); } } while (0)
    ATT_LOAD(0, 0); ATT_LOAD(1, 1); ATT_LOAD(2, 2);
    __syncthreads();
    *(LAS u32x4*)(sb + ldst) = kR[0]; *(LAS u32x4*)(sb + PBUF + ldst) = vR[0];
    __syncthreads();
    for (int pi0 = 0; pi0 < npair; pi0 += 3) {
#pragma unroll
      for (int jj = 0; jj < 3; ++jj) {
        const int pi = pi0 + jj;
        if (pi < npair) {
        const bool more = pi + 1 < npair;
        if (jj == 0) ATT_LOAD(0, pi + 3); else if (jj == 1) ATT_LOAD(1, pi + 3); else ATT_LOAD(2, pi + 3);
        const int wrow = rsU + pi - 4;
        const bool mine = (kind != 0) || pi < 4 || (wrow >= rs && wrow < rs + 8);
        if (mine) {
            const LAS unsigned char* kb_ = sb + (pi & 1) * STG;
            const LAS unsigned char* vb_ = kb_ + PBUF;
            bf16x8 kf[2][4];
#pragma unroll
            for (int u = 0; u < 2; ++u)
#pragma unroll
                for (int s = 0; s < 4; ++s) kf[u][s] = *(const LAS bf16x8*)(kb_ + (32 * u + r) * VROW + (16 * s + 8 * hf) * 2);
            f32x16 x0, x1;
#pragma unroll
            for (int i = 0; i < 16; ++i) { x0[i] = 0.f; x1[i] = 0.f; }
#pragma unroll
            for (int s = 0; s < 4; ++s) { x0 = __builtin_amdgcn_mfma_f32_32x32x16_bf16(kf[0][s], qf[s], x0, 0, 0, 0); x1 = __builtin_amdgcn_mfma_f32_32x32x16_bf16(kf[1][s], qf[s], x1, 0, 0, 0); }
            const bool win = (kind == 0 && pi >= 4);
            bool lv[2][4];
#pragma unroll
            for (int g = 0; g < 4; ++g) { lv[0][g] = !win || hq == 0 || g == 3; lv[1][g] = !win || hq == 1 || g == 0; }
            if (win) {
                const int ridx = wrow - grow + 7;
                int csl = cs - 4 * hf, bl = 4 * hf - qc + 15;
                asm volatile("" : "+v"(csl), "+v"(bl));
                const LAS float* rp = rpbL + ridx * 31 + bl;
#pragma unroll
                for (int g = 0; g < 4; ++g) {
                    if (lv[0][g]) {
#pragma unroll
                        for (int jx = 0; jx < 4; ++jx) { const int i = 4 * g + jx, ci = jx + 8 * g; const bool valid = (unsigned)(ci - csl) < 16u; const float bias = rp[ci]; x0[i] = valid ? x0[i] + bias : -1e30f; }
                    }
                    if (lv[1][g]) {
#pragma unroll
                        for (int jx = 0; jx < 4; ++jx) { const int i = 4 * g + jx, ci = jx + 8 * g; const bool valid = (unsigned)(ci + 32 - csl) < 16u; const float bias = rp[ci + 32]; x1[i] = valid ? x1[i] + bias : -1e30f; }
                    }
                }
            }
            float mx = -1e30f;
#pragma unroll
            for (int g = 0; g < 4; ++g) {
                if (lv[0][g]) mx = fmaxf(fmaxf(mx, fmaxf(x0[4 * g], x0[4 * g + 1])), fmaxf(x0[4 * g + 2], x0[4 * g + 3]));
                if (lv[1][g]) mx = fmaxf(fmaxf(mx, fmaxf(x1[4 * g], x1[4 * g + 1])), fmaxf(x1[4 * g + 2], x1[4 * g + 3]));
            }
            mx = fmaxf(mx, __shfl_xor(mx, 32));
            const bool rebase = __builtin_amdgcn_ballot_w64(mx > mrun + 8.0f) != 0ull;
            const float mnew = rebase ? fmaxf(mrun, mx) : mrun;
            float psum = 0.f;
#pragma unroll
            for (int g = 0; g < 4; ++g) {
                if (lv[0][g]) {
#pragma unroll
                    for (int jx = 0; jx < 4; ++jx) { const int i = 4 * g + jx; x0[i] = __builtin_amdgcn_exp2f(x0[i] - mnew); psum += x0[i]; }
                } else {
#pragma unroll
                    for (int jx = 0; jx < 4; ++jx) x0[4 * g + jx] = 0.f;
                }
                if (lv[1][g]) {
#pragma unroll
                    for (int jx = 0; jx < 4; ++jx) { const int i = 4 * g + jx; x1[i] = __builtin_amdgcn_exp2f(x1[i] - mnew); psum += x1[i]; }
                } else {
#pragma unroll
                    for (int jx = 0; jx < 4; ++jx) x1[4 * g + jx] = 0.f;
                }
            }
            if (rebase) {
                const float alpha = __builtin_amdgcn_exp2f(mrun - mnew);
                lrun *= alpha; mrun = mnew;
#pragma unroll
                for (int i = 0; i < 16; ++i) { o0[i] *= alpha; o1[i] *= alpha; }
            }
            lrun += psum;
            const int q4 = (lane & 15) >> 2, p4 = lane & 3, blk = (lane >> 4) & 1;
#pragma unroll
            for (int u = 0; u < 2; ++u) {
                const LAS unsigned char* vcur = vb_ + (32 * u + 4 * hf + q4) * VROW + (16 * blk + 4 * p4) * 2;
#pragma unroll
                for (int s2 = 0; s2 < 2; ++s2) {
                    if (lv[u][2 * s2] || lv[u][2 * s2 + 1]) {
                        s16x4 lo[2], hi[2];
#pragma unroll
                        for (int db = 0; db < 2; ++db) { lo[db] = tr_read(vcur + (16 * s2) * VROW + 64 * db); hi[db] = tr_read(vcur + (16 * s2 + 8) * VROW + 64 * db); }
                        u32x4 pw;
                        if (u == 0) { pw.x = pk2(x0[8 * s2 + 0], x0[8 * s2 + 1]); pw.y = pk2(x0[8 * s2 + 2], x0[8 * s2 + 3]); pw.z = pk2(x0[8 * s2 + 4], x0[8 * s2 + 5]); pw.w = pk2(x0[8 * s2 + 6], x0[8 * s2 + 7]); }
                        else        { pw.x = pk2(x1[8 * s2 + 0], x1[8 * s2 + 1]); pw.y = pk2(x1[8 * s2 + 2], x1[8 * s2 + 3]); pw.z = pk2(x1[8 * s2 + 4], x1[8 * s2 + 5]); pw.w = pk2(x1[8 * s2 + 6], x1[8 * s2 + 7]); }
                        const bf16x8 pb = __builtin_bit_cast(bf16x8, pw);
                        const bf16x8 va0 = __builtin_shufflevector(lo[0], hi[0], 0, 1, 2, 3, 4, 5, 6, 7);
                        const bf16x8 va1 = __builtin_shufflevector(lo[1], hi[1], 0, 1, 2, 3, 4, 5, 6, 7);
                        o0 = __builtin_amdgcn_mfma_f32_32x32x16_bf16(va0, pb, o0, 0, 0, 0);
                        o1 = __builtin_amdgcn_mfma_f32_32x32x16_bf16(va1, pb, o1, 0, 0, 0);
                    }
                }
            }
        }
        if (more) {
            LAS unsigned char* nb = sb + ((pi + 1) & 1) * STG;
            const int jn = (jj + 1) % 3;
            *(LAS u32x4*)(nb + ldst) = kR[jn]; *(LAS u32x4*)(nb + PBUF + ldst) = vR[jn];
        }
        __syncthreads();
        }
      }
    }
#undef ATT_LOAD
    const float ltot = lrun + __shfl_xor(lrun, 32);
    const float inv = 1.0f / ltot;
    bf16_t* zrow = Gb + (size_t)qtok * 1024 + h * 64;
    u32x2 z[2][4];
#pragma unroll
    for (int db = 0; db < 2; ++db)
#pragma unroll
        for (int g = 0; g < 4; ++g) z[db][g] = *(const u32x2*)(zrow + 32 * db + 8 * g + 4 * hf);
#pragma unroll
    for (int db = 0; db < 2; ++db)
#pragma unroll
        for (int g = 0; g < 4; ++g) {
            const int d0 = 32 * db + 8 * g + 4 * hf;
            float ov[4];
#pragma unroll
            for (int j = 0; j < 4; ++j) ov[j] = (db == 0 ? o0[4 * g + j] : o1[4 * g + j]) * inv;
            u32x2 w; w.x = pk2(ov[0] * bflo(z[db][g].x), ov[1] * bfhi(z[db][g].x)); w.y = pk2(ov[2] * bflo(z[db][g].y), ov[3] * bfhi(z[db][g].y));
            if (!dry) *(u32x2*)(zrow + d0) = w;
        }
}

DI void pool_tasks(const Args& A, int gt, int GT, int dry) {
    const bf16_t* UC = (const bf16_t*)(A.ws + WS_UC); bf16_t* ZC = (bf16_t*)(A.ws + WS_G) + 768;
    for (int task = gt; task < T * 32; task += GT) {
        const int g = __builtin_amdgcn_readfirstlane(task / (T * 8)), rem = task - g * (T * 8), t = rem >> 3, c0 = g * 64 + (rem & 7) * 8, half = 1 << g;
        int tb, pos, L;
        if (t < TP) { tb = t & ~255; pos = t & 255; L = 256; } else { const int ts = t - TP; tb = TP + (ts & ~2047); pos = ts & 2047; L = 2048; }
        const int lo = max(pos - half, 0), hi = min(pos + half, L);
        float sum[8] = {0.f, 0.f, 0.f, 0.f, 0.f, 0.f, 0.f, 0.f};
#pragma unroll
        for (int j = 0; j < 16; ++j) {
            if (j >= 2 * half) break;
            const int p = lo + j; const bool ok = p < hi;
            const u32x4 w = *(const u32x4*)(UC + (size_t)(tb + (ok ? p : pos)) * 256 + c0);
            if (ok) { sum[0] += bflo(w.x); sum[1] += bfhi(w.x); sum[2] += bflo(w.y); sum[3] += bfhi(w.y); sum[4] += bflo(w.z); sum[5] += bfhi(w.z); sum[6] += bflo(w.w); sum[7] += bfhi(w.w); }
        }
        const float inv = __builtin_amdgcn_rcpf((float)(hi - lo));
        const u32x4 sf = *(const u32x4*)(UC + (size_t)t * 256 + c0);
        const u32x4 z = *(const u32x4*)(ZC + (size_t)t * 1024 + c0);
        const float s[8] = {bflo(sf.x), bfhi(sf.x), bflo(sf.y), bfhi(sf.y), bflo(sf.z), bfhi(sf.z), bflo(sf.w), bfhi(sf.w)};
        const float zz[8] = {bflo(z.x), bfhi(z.x), bflo(z.y), bfhi(z.y), bflo(z.z), bfhi(z.z), bflo(z.w), bfhi(z.w)};
        float o[8];
#pragma unroll
        for (int i = 0; i < 8; ++i) o[i] = zz[i] * (sum[i] * inv - s[i]);
        if (!dry) *(u32x4*)(ZC + (size_t)t * 1024 + c0) = pk8(o);
    }
}

DI void phase_mix(const Args& A, int l, LAS unsigned char* lds, int dry, int parts, bool sw_here) {
    const int tid = otid(), lane = tid & 63, wid = __builtin_amdgcn_readfirstlane(tid >> 6);
    const int c = blockIdx.x, G = gridDim.x;
    if (parts & 1) {
        FourSched S{(const char*)(A.ws + WS_DS), (const char*)(A.ws + WS_DP), (const char*)(A.ws + WS_VTS), (const char*)(A.ws + WS_VTP), c, G};
        EpiFour E{(bf16_t*)(A.ws + WS_XH), (bf16_t*)(A.ws + WS_XH) + 8ull * 8192 * 256};
        pg8::gemm_phase<EpiFour, FourSched>(lds, 512, 512, 8, S, E);
    }
    if (parts & 2) {
    for (int i = tid; i < 8 * 465; i += blockDim.x) ((LAS float*)lds)[64 + i] = A.rpb[(size_t)l * 8 * 465 + i] * LOG2E;
    __syncthreads();
    if (G == 256) {
        { const int wt = c; const int b = wt >> 6, h = (wt >> 3) & 7, r4 = wt & 7; attn_wg(A, l, 0, b, h, r4, lds, wid, lane, tid, dry); }
        if (c >= 144) {
            { const int m = c - 144; const int b = m >> 3, h = m & 7; attn_wg(A, l, 1, b, h, 0, lds, wid, lane, tid, dry); }
            const int r4c = c & 7; const int idx = r4c == 0 ? ((c - 144) >> 3) : (r4c == 7 ? 14 + ((c - 151) >> 3) : 99);
            if (idx < 16) { const int m = 112 + idx; const int b = m >> 3, h = m & 7; attn_wg(A, l, 1, b, h, 0, lds, wid, lane, tid, dry); }
        }
    } else
    for (int wt = c; wt < 384; wt += G) {
        if (wt < 256) { const int b = wt >> 6, h = (wt >> 3) & 7, r4 = wt & 7; attn_wg(A, l, 0, b, h, r4, lds, wid, lane, tid, dry); }
        else { const int m = wt - 256; const int b = m >> 3, h = m & 7; attn_wg(A, l, 1, b, h, 0, lds, wid, lane, tid, dry); }
    }
    }
    if (parts & 4) {
        {
            const bf16_t* VTS = (const bf16_t*)(A.ws + WS_VTS); float* Y1K = (float*)(A.ws + WS_Y1K);
            const int gw = __builtin_amdgcn_readfirstlane((blockIdx.x * blockDim.x + tid) >> 6), GW = (gridDim.x * blockDim.x) >> 6;
            for (int task = gw; task < 1024; task += GW) {
                const int b = task >> 8, e = task & 255;
                const bf16_t* row = VTS + ((size_t)(b * 8 + (lane >> 4)) * 256 + e) * 512 + (lane & 15) * 32;
                float a = 0.f;
#pragma unroll
                for (int q = 0; q < 4; ++q) { const u32x4 w = *(const u32x4*)(row + q * 8);
                    a += (bflo(w.x) - bfhi(w.x)) + (bflo(w.y) - bfhi(w.y)) + (bflo(w.z) - bfhi(w.z)) + (bflo(w.w) - bfhi(w.w)); }
#pragma unroll
                for (int o = 32; o >= 1; o >>= 1) a += __shfl_xor(a, o);
                if (lane == 0 && !dry) Y1K[(task & ~255) + pcol(e)] = a * (1.0f / sqrtf(2048.0f * 64.0f));
            }
        }
        pool_tasks(A, blockIdx.x * blockDim.x + tid, gridDim.x * blockDim.x, dry);
        if (sw_here && !dry) { const int gw2 = __builtin_amdgcn_readfirstlane((blockIdx.x * blockDim.x + tid) >> 6); sw_tasks(A, gw2, (gridDim.x * blockDim.x) >> 6, lane); }
    }
    __syncthreads();
}

DI void phase_gb(const Args& A, int dry) {
    const int gt = blockIdx.x * blockDim.x + otid(), GT = gridDim.x * blockDim.x;
    const bf16_t* YS = (const bf16_t*)(A.ws + WS_XH); const bf16_t* YP = YS + 8ull * 8192 * 256; bf16_t* ZB = (bf16_t*)(A.ws + WS_G) + 512;
    for (int task = gt; task < T * 32; task += GT) {
        const int tt = task >> 5, c0 = (task & 31) * 8;
        const int t = tt < TS ? TP + tt : tt - TS;
        float s[8] = {0.f, 0.f, 0.f, 0.f, 0.f, 0.f, 0.f, 0.f};
        const u32x4 z = *(const u32x4*)(ZB + (size_t)t * 1024 + c0);
        if (t < TP) {
            const u32x4 w = *(const u32x4*)(YP + (size_t)t * 256 + c0);
            s[0] = bflo(w.x); s[1] = bfhi(w.x); s[2] = bflo(w.y); s[3] = bfhi(w.y); s[4] = bflo(w.z); s[5] = bfhi(w.z); s[6] = bflo(w.w); s[7] = bfhi(w.w);
        } else {
            const int ts = t - TP, k1 = ts & 2047;
            if (k1 == 1024) {
                const float* y = (const float*)(A.ws + WS_Y1K) + (ts >> 11) * 256 + c0;
                const f32x4 y0 = *(const f32x4*)y, y1 = *(const f32x4*)(y + 4);
                s[0] = y0[0]; s[1] = y0[1]; s[2] = y0[2]; s[3] = y0[3]; s[4] = y1[0]; s[5] = y1[1]; s[6] = y1[2]; s[7] = y1[3];
            } else {
                const int src = (ts & ~2047) + (k1 < 1024 ? k1 : 2048 - k1);
                const float sg = k1 < 1024 ? 1.0f : -1.0f;
                u32x4 w[8];
#pragma unroll
                for (int kc = 0; kc < 8; ++kc) w[kc] = *(const u32x4*)(YS + ((size_t)kc * 8192 + src) * 256 + c0);
#pragma unroll
                for (int kc = 0; kc < 8; ++kc) { const float f = kc < 4 ? 1.0f : sg;
                    s[0] += f * bflo(w[kc].x); s[1] += f * bfhi(w[kc].x); s[2] += f * bflo(w[kc].y); s[3] += f * bfhi(w[kc].y); s[4] += f * bflo(w[kc].z); s[5] += f * bfhi(w[kc].z); s[6] += f * bflo(w[kc].w); s[7] += f * bfhi(w[kc].w); }
            }
        }
        float o[8] = {s[0] * bflo(z.x), s[1] * bfhi(z.x), s[2] * bflo(z.y), s[3] * bfhi(z.y), s[4] * bflo(z.z), s[5] * bfhi(z.z), s[6] * bflo(z.w), s[7] * bfhi(z.w)};
        if (!dry) *(u32x4*)(ZB + (size_t)t * 1024 + c0) = pk8(o);
    }
}

struct TileSched {
    const char* Ab; const char* Bb; size_t tileA, tileB; int c, G;
    DI bool next(int i, Unit& u) const { const int f = i * G + c; if (f >= 192) return false; const int pm = f >> 2, pn = f & 3; u.a = Ab + pm * tileA; u.b = Bb + pn * tileB; u.k0 = 0; u.k1 = pm; u.k2 = pn; u.k3 = 0; return true; }
};
struct HookProj {
    static constexpr bool ENABLED = true;
    const bf16_t* SG;
    DI void operator()(f32x4 (&acc)[2][2][4][2], const Unit& u, int t, int wr, int wc, int fr, int fq) const {
        LAUNDER();
        const size_t GT_ = (size_t)48 * 4 * 65536;
        const bf16_t* sp = SG + (t == 8 ? (size_t)0 : GT_) + ((size_t)u.k1 * 4 + u.k2) * 65536 + (size_t)((wr * 4 + wc) * 16 * 64 + fq * 16 + fr) * 8;
#pragma unroll
        for (int ai = 0; ai < 2; ++ai) {
            u32x4 gn[8], gd[8];
#pragma unroll
            for (int q = 0; q < 8; ++q) { gn[q] = __builtin_nontemporal_load((const u32x4*)(sp + (size_t)((ai * 8 + q) * 64) * 8)); gd[q] = *(const u32x4*)(sp + GT_ + (size_t)((ai * 8 + q) * 64) * 8); }
#pragma unroll
            for (int m = 0; m < 4; ++m)
#pragma unroll
                for (int bj = 0; bj < 2; ++bj) {
                    const u32x4 a = gn[m * 2 + bj], d = gd[m * 2 + bj];
                    f32x4 v0 = acc[ai][bj][m][0], v1 = acc[ai][bj][m][1];
                    v0[0] *= bflo(a.x) * __builtin_amdgcn_rcpf(fmaxf(bflo(d.x), 1e-30f)); v0[1] *= bfhi(a.x) * __builtin_amdgcn_rcpf(fmaxf(bfhi(d.x), 1e-30f));
                    v0[2] *= bflo(a.y) * __builtin_amdgcn_rcpf(fmaxf(bflo(d.y), 1e-30f)); v0[3] *= bfhi(a.y) * __builtin_amdgcn_rcpf(fmaxf(bfhi(d.y), 1e-30f));
                    v1[0] *= bflo(a.z) * __builtin_amdgcn_rcpf(fmaxf(bflo(d.z), 1e-30f)); v1[1] *= bfhi(a.z) * __builtin_amdgcn_rcpf(fmaxf(bfhi(d.z), 1e-30f));
                    v1[2] *= bflo(a.w) * __builtin_amdgcn_rcpf(fmaxf(bflo(d.w), 1e-30f)); v1[3] *= bfhi(a.w) * __builtin_amdgcn_rcpf(fmaxf(bfhi(d.w), 1e-30f));
                    acc[ai][bj][m][0] = v0; acc[ai][bj][m][1] = v1;
                }
        }
    }
};
struct EpiProj {
    const bf16_t* SGc; bf16_t* MG;
    DI void operator()(const f32x4 (&acc)[2][2][4][2], const Unit& u, int wr, int wc, int fr, int fq) const {
        LAUNDER();
        const bf16_t* sp = SGc + ((size_t)u.k1 * 4 + u.k2) * 65536 + (size_t)((wr * 4 + wc) * 16 * 64 + fq * 16 + fr) * 8;
#pragma unroll
        for (int ai = 0; ai < 2; ++ai) {
            u32x4 gc[8];
#pragma unroll
            for (int q = 0; q < 8; ++q) gc[q] = __builtin_nontemporal_load((const u32x4*)(sp + (size_t)((ai * 8 + q) * 64) * 8));
#pragma unroll
            for (int m = 0; m < 4; ++m) {
                const int t = 256 * u.k1 + 128 * ai + 64 * wr + 16 * m + fr;
                bf16_t* rowp = MG + (size_t)t * 1024 + 256 * u.k2 + 32 * wc + 8 * fq;
#pragma unroll
                for (int bj = 0; bj < 2; ++bj) {
                    const u32x4 g = gc[m * 2 + bj];
                    const f32x4 v0 = acc[ai][bj][m][0], v1 = acc[ai][bj][m][1];
                    u32x2 w0; w0.x = pk2(v0[0] * bflo(g.x), v0[1] * bfhi(g.x)); w0.y = pk2(v0[2] * bflo(g.y), v0[3] * bfhi(g.y));
                    u32x2 w1; w1.x = pk2(v1[0] * bflo(g.z), v1[1] * bfhi(g.z)); w1.y = pk2(v1[2] * bflo(g.w), v1[3] * bfhi(g.w));
                    u32x4 w01; w01.x = w0.x; w01.y = w0.y; w01.z = w1.x; w01.w = w1.y; *(u32x4*)(rowp + 128 * bj) = w01;
                }
            }
        }
    }
};
struct EpiOut {
    const float* xp; const float* xs; float* out; const float* ng1; int l; const float* ada; int dry; bf16_t* XG; float* rss;
    DI void operator()(const f32x4 (&acc)[2][2][4][2], const Unit& u, int wr, int wc, int fr, int fq) const {
        LAUNDER();
        const int t0 = 256 * u.k1; const int j = cond_of(t0);
        const int cb = 256 * u.k2 + 32 * wc + 8 * fq;
        const float* gate = ada + (size_t)(l * 5 + j) * 3072 + 2048 + cb;
        f32x4 gv[2][2], gm[2][2];
#pragma unroll
        for (int bj = 0; bj < 2; ++bj)
#pragma unroll
            for (int n = 0; n < 2; ++n) {
                gv[bj][n] = *(const f32x4*)(gate + 128 * bj + 4 * n);
                gm[bj][n] = (f32x4){0.f, 0.f, 0.f, 0.f};
                if (XG) gm[bj][n] = *(const f32x4*)(ng1 + cb + 128 * bj + 4 * n) * (*(const f32x4*)(ada + (size_t)(5 + j) * 3072 + 1024 + cb + 128 * bj + 4 * n) + 1.0f);
            }
#pragma unroll
        for (int ai = 0; ai < 2; ++ai)
#pragma unroll
            for (int mh = 0; mh < 2; ++mh) {
                f32x4 xv[2][2][2];
#pragma unroll
                for (int mm = 0; mm < 2; ++mm) {
                    const int t = t0 + 128 * ai + 64 * wr + 16 * (2 * mh + mm) + fr;
                    const float* xr = (l == 0 ? (t < TP ? xp + (size_t)t * 1024 : xs + (size_t)(t - TP) * 1024) : out + (size_t)t * 1024) + cb;
#pragma unroll
                    for (int bj = 0; bj < 2; ++bj)
#pragma unroll
                        for (int n = 0; n < 2; ++n) xv[mm][bj][n] = *(const f32x4*)(xr + 128 * bj + 4 * n);
                }
#pragma unroll
                for (int mm = 0; mm < 2; ++mm) {
                    const int m = 2 * mh + mm;
                    const int t = t0 + 128 * ai + 64 * wr + 16 * m + fr;
                    float* orow = out + (size_t)t * 1024 + cb;
                    float ssq = 0.f;
#pragma unroll
                    for (int bj = 0; bj < 2; ++bj) {
                        const f32x4 xn0 = xv[mm][bj][0] + gv[bj][0] * acc[ai][bj][m][0], xn1 = xv[mm][bj][1] + gv[bj][1] * acc[ai][bj][m][1];
                        if (!dry) { *(f32x4*)(orow + 128 * bj) = xn0; *(f32x4*)(orow + 128 * bj + 4) = xn1; }
                        if (XG) {
                            const f32x4 y0 = xn0 * gm[bj][0], y1 = xn1 * gm[bj][1];
                            u32x4 w; w.x = pk2(y0[0], y0[1]); w.y = pk2(y0[2], y0[3]); w.z = pk2(y1[0], y1[1]); w.w = pk2(y1[2], y1[3]);
                            if (!dry) *(u32x4*)(XG + (size_t)t * 1024 + cb + 128 * bj) = w;
                            ssq += xn0[0] * xn0[0] + xn0[1] * xn0[1] + xn0[2] * xn0[2] + xn0[3] * xn0[3] + xn1[0] * xn1[0] + xn1[1] * xn1[1] + xn1[2] * xn1[2] + xn1[3] * xn1[3];
                        }
                    }
                    if (XG) {
                        ssq += __shfl_xor(ssq, 16); ssq += __shfl_xor(ssq, 32);
                        if (fq == 0 && !dry) atomicAdd(rss + t, ssq);
                    }
                }
            }
    }
};

__global__ void __launch_bounds__(512, 2) mk_fwd(Args A0) {
    const Args& A = A0;
    extern __shared__ __attribute__((aligned(16))) unsigned char lds_raw[];
    LAS unsigned char* lds = (LAS unsigned char*)lds_raw;
    cg::grid_group grid = cg::this_grid();
    const int lo = A.ph_lo, hi = A.ph_hi;
    if (threadIdx.x < 4) ((LAS unsigned*)(lds + LDS_RING))[threadIdx.x] = 0u;
    __syncthreads();
    XcdBarrier xbar = xcd_barrier_post((unsigned*)(A.ws + WS_BAR), (volatile LAS unsigned*)(lds + LDS_RING));
    if (hi > 1000) grid.sync();
    const int c = blockIdx.x, G = gridDim.x;
    const bool fuse1 = (lo == 0 && hi == 14);
#define IN(k) (lo <= (k) && (k) < hi)
#define SEAM(k) do { if (IN(k) && IN((k) + 1)) xcd_barrier(xbar); } while (0)
#if defined(PROBE_PHASE)
#define NREPS(k) (((k) == PROBE_PHASE) ? 1 + PROBE_REPS : 1)
#else
#define NREPS(k) 1
#endif
#if defined(PROBE_PARTS)
#define PARTS(dry) ((dry) ? PROBE_PARTS : 7)
#else
#define PARTS(dry) 7
#endif
#define PHASE(k, ...) do { if (IN(k)) { const int nreps_ = NREPS(k); for (int rep_ = 0; rep_ < nreps_; ++rep_) { const int dry = rep_ > 0; (void)dry; if (rep_ > 0) xcd_barrier(xbar); \
        KArgP ap_ = (KArgP)__builtin_amdgcn_kernarg_segment_ptr(); asm volatile("" : "+s"(ap_)); \
        const Args& A = *(const Args*)ap_;     \
        __VA_ARGS__ } } SEAM(k); } while (0)
#if defined(PROBE_A_REPS)
    for (int r = 0; r < PROBE_A_REPS; ++r) phase_a(A, fuse1, lds);
#endif
    PHASE(0, phase_a(A, fuse1, lds););
#if defined(PROBE_SYNCS)
    for (int r = 0; r < PROBE_SYNCS; ++r) xcd_barrier(xbar);
#endif
    PHASE(1, { phase_b(A, lds, fuse1); if (fuse1) phase_norm(A, 0, false); });
    for (int l = 0; l < 2; ++l) {
        const int p0 = 2 + 6 * l;
        if (!fuse1) PHASE(p0, phase_norm(A, l, true););
        PHASE(p0 + 1, {
            InSched S{(const char*)(A.ws + WS_XH), (const char*)(A.ws + WS_WIN + (size_t)l * WIN_L), c, G};
            EpiIn E{l, (l == 1 && fuse1) ? 1 : 0, A.ws, A.out + (size_t)T * 1024, A.q_g, A.k_g};
            pg8::gemm_phase<EpiIn, InSched>(lds, 1024, 1024, 16, S, E);
        });
        PHASE(p0 + 2, phase_mix(A, l, lds, dry, PARTS(dry), fuse1 && l == 0););
        PHASE(p0 + 3, phase_gb(A, dry););
        PHASE(p0 + 4, {
            const bf16_t* SG = (const bf16_t*)(A.ws + WS_SG);
            TileSched S{(const char*)(A.ws + WS_G), (const char*)(A.ws + WS_PT + (size_t)l * 1024 * 1024 * 2), TILE1K, TILE1K, c, G};
            EpiProj E{SG + 2 * (size_t)48 * 4 * 65536, (bf16_t*)(A.ws + WS_QB)};
            HookProj H{SG};
            pg8::gemm_phase<EpiProj, TileSched, HookProj>(lds, 1024, 1024, 16, S, E, H);
        });
        PHASE(p0 + 5, {
            TileSched S{(const char*)(A.ws + WS_QB), (const char*)(A.ws + WS_WO + (size_t)l * 1024 * 1024 * 2), TILE1K, TILE1K, c, G};
            EpiOut E{A.x_prompt, A.x_sample, A.out, A.norm_g + 1024, l, (const float*)(A.ws + WS_ADA), dry, (l == 0 && fuse1) ? (bf16_t*)(A.ws + WS_XH) : (bf16_t*)nullptr, (float*)(A.ws + WS_RSS)};
            pg8::gemm_phase<EpiOut, TileSched>(lds, 1024, 1024, 16, S, E);
        });
    }
#undef IN
#undef SEAM
}

extern "C" void kernel_launch(void* const* d_in, const int* in_sizes, int n_in, void* d_out, int out_size, void* d_ws, size_t ws_size, hipStream_t stream) {
    static int grid = 0;
    if (grid == 0) {
        if (ws_size < WS_END) { fprintf(stderr, "kernel_launch: workspace too small: %zu < %zu\n", ws_size, (size_t)WS_END); grid = -1; return; }
        int dev = 0, cus = 0, per_cu = 0;
        hipGetDevice(&dev);
        hipDeviceGetAttribute(&cus, hipDeviceAttributeMultiprocessorCount, dev);
        if (hipFuncSetAttribute((const void*)mk_fwd, hipFuncAttributeMaxDynamicSharedMemorySize, LDS_BYTES) != hipSuccess) { fprintf(stderr, "kernel_launch: hipFuncSetAttribute failed\n"); grid = -1; return; }
        hipOccupancyMaxActiveBlocksPerMultiprocessor(&per_cu, (const void*)mk_fwd, 512, LDS_BYTES);
        (void)hipGetLastError();
        if (per_cu < 1) per_cu = 1;
        grid = cus;
        if (grid <= 0) grid = 256;
    }
    if (grid < 0) return;
    Args a{};
    a.x_prompt = (const float*)d_in[0]; a.x_sample = (const float*)d_in[1]; a.cache_k = (const float*)d_in[2]; a.cache_v = (const float*)d_in[3];
    a.c = (const float*)d_in[4]; a.c_ctx = (const float*)d_in[5]; a.norm_g = (const float*)d_in[6]; a.w_ada = (const float*)d_in[7]; a.b_ada = (const float*)d_in[8];
    a.w_in = (const float*)d_in[9]; a.q_g = (const float*)d_in[10]; a.k_g = (const float*)d_in[11]; a.rpb = (const float*)d_in[12]; a.w_fnet = (const float*)d_in[13];
    a.w_pool = (const float*)d_in[14]; a.pool_scale = (const float*)d_in[15]; a.p_a = (const float*)d_in[16]; a.p_b = (const float*)d_in[17]; a.p_c = (const float*)d_in[18]; a.w_o = (const float*)d_in[19];
    a.out = (float*)d_out; a.ws = (unsigned char*)d_ws;
#if MK_SINGLE
    if (hipMemsetAsync((char*)d_ws + WS_BAR, 0, ZERO_BYTES, stream) != hipSuccess) { fprintf(stderr, "kernel_launch: memset of the barrier words failed\n"); return; }
    if (hipMemsetAsync((char*)d_ws + WS_ADA, 0, 2ull * 5 * 3072 * 4, stream) != hipSuccess) { fprintf(stderr, "kernel_launch: memset of ADA failed\n"); return; }
    a.ph_lo = 0; a.ph_hi = 14;
    void* args[] = {&a};
    hipError_t e = hipLaunchCooperativeKernel((const void*)mk_fwd, dim3(grid), dim3(512), args, LDS_BYTES, stream);
    if (e != hipSuccess) fprintf(stderr, "cooperative launch failed: %s (grid %d)\n", hipGetErrorString(e), grid);
#else
    for (int p = 0; p < 14; ++p) {
        a.ph_lo = p; a.ph_hi = p + 1;
        hipLaunchKernelGGL(mk_fwd, dim3(grid), dim3(512), LDS_BYTES, stream, a);
    }
#endif
}
```

```cpp
#include <hip/hip_runtime.h>
#include <hip/hip_cooperative_groups.h>
#include <cstdio>
#include <cstdint>
namespace cg = cooperative_groups;

#ifndef MK_SINGLE
#define MK_SINGLE 1
#endif

#define LAS __attribute__((address_space(3)))
typedef unsigned short bf16_t;
typedef short bf16x8 __attribute__((ext_vector_type(8)));
typedef short s16x4 __attribute__((ext_vector_type(4)));
typedef float f32x2 __attribute__((ext_vector_type(2)));
typedef float f32x4 __attribute__((ext_vector_type(4)));
typedef float f32x16 __attribute__((ext_vector_type(16)));
typedef unsigned u32x2 __attribute__((ext_vector_type(2)));
typedef unsigned u32x4 __attribute__((ext_vector_type(4)));
typedef __bf16 bf16x2_t __attribute__((ext_vector_type(2)));

#define DI __device__ __forceinline__
#define LAUNDER() asm volatile("" : "+v"(fr), "+v"(fq), "+s"(wr), "+s"(wc))

DI int otid() { int t = threadIdx.x; asm volatile("" : "+v"(t)); return t; }
DI unsigned pk2(float lo, float hi) { f32x2 v = {lo, hi}; bf16x2_t b = __builtin_convertvector(v, bf16x2_t); return __builtin_bit_cast(unsigned, b); }
DI float bflo(unsigned w) { return __uint_as_float(w << 16); }
DI float bfhi(unsigned w) { return __uint_as_float(w & 0xffff0000u); }
DI u32x4 pk8(const float* v) { u32x4 w; w.x = pk2(v[0], v[1]); w.y = pk2(v[2], v[3]); w.z = pk2(v[4], v[5]); w.w = pk2(v[6], v[7]); return w; }
DI float sigmoidf_(float v) { return __builtin_amdgcn_rcpf(1.0f + __builtin_amdgcn_exp2f(-1.4426950408889634f * v)); }

constexpr int T = 12288, TP = 4096, TS = 8192, DM = 1024, INW = 6144;
constexpr float LOG2E = 1.4426950408889634f;
constexpr float EPS = 1e-6f;

constexpr size_t WS_ADAP = 0;
constexpr size_t WS_ADA  = WS_ADAP + 16ull * 2 * 5 * 3072 * 4;
constexpr size_t WS_MCS  = WS_ADA + 2ull * 5 * 3072 * 4;
constexpr size_t WS_WIN  = WS_MCS + 2ull * 2 * 256 * 256 * 4;
constexpr size_t WIN_L   = 6400ull * 1024 * 2;
constexpr size_t WS_PT   = WS_WIN + 2 * WIN_L;
constexpr size_t WS_WO   = WS_PT + 2ull * 1024 * 1024 * 2;
constexpr size_t WS_DS   = WS_WO + 2ull * 1024 * 1024 * 2;
constexpr size_t WS_DP   = WS_DS + 2048ull * 4096 * 2;
constexpr size_t WS_CK   = WS_DP + 256ull * 4096 * 2;
constexpr size_t WS_CV   = WS_CK + 4ull * 2 * 8 * 256 * 64 * 2;
constexpr size_t WS_XH   = WS_CV + 4ull * 2 * 8 * 256 * 64 * 2;
constexpr size_t YBP_BYTES = 8ull * 8192 * 256 * 2 + 4096ull * 256 * 2;
constexpr size_t WS_QB   = WS_XH + YBP_BYTES;
constexpr size_t WS_KB   = WS_QB + (size_t)T * 512 * 2;
constexpr size_t WS_VB   = WS_KB + (size_t)T * 512 * 2;
constexpr size_t WS_VTS  = WS_VB + (size_t)T * 512 * 2;
constexpr size_t WS_VTP  = WS_VTS + 2ull * 256 * 8192 * 2;
constexpr size_t WS_G    = WS_VTP + 256ull * 8192 * 2;
constexpr size_t WS_UC   = WS_G + (size_t)T * 1024 * 2;
constexpr size_t WS_SG   = WS_UC + (size_t)T * 256 * 2;
constexpr size_t WS_BAR  = WS_SG + 3ull * T * 1024 * 2;
constexpr size_t WS_RSS  = WS_BAR + 16384;
constexpr size_t WS_SW   = WS_RSS + (size_t)T * 4;
constexpr size_t WS_Y1K  = WS_SW + 5ull * 6400 * 4;
constexpr size_t WS_END  = WS_Y1K + 4ull * 256 * 4;
constexpr size_t ZERO_BYTES = 16384 + (size_t)T * 4;
static_assert(WS_END <= 268435456ull, "workspace");

constexpr int LDS_RING = 131072;
constexpr int LDS_BYTES = LDS_RING + 16;

namespace pg8 {
constexpr int BM = 256, BK = 64, HALF = 128, HTB = HALF * BK * 2;
DI int lds_byte(int r, int c) { const int st = (r >> 4) * 2 + (c >> 5), rr = r & 15, cc = c & 31, ob = rr * 64 + cc * 2; return st * 1024 + (ob ^ (((ob >> 9) & 1) << 5)); }
DI void stage_rc(int b, int& R, int& C) { const int st = b / 1024, sb = b % 1024, swz = sb ^ (((sb >> 9) & 1) << 5); R = (st >> 1) * 16 + swz / 64; C = (st & 1) * 32 + (swz % 64) / 2; }
struct Unit { const char* a; const char* b; int k0, k1, k2, k3; };

struct NoHook { static constexpr bool ENABLED = false; DI void operator()(f32x4 (&)[2][2][4][2], const Unit&, int, int, int, int, int) const {} };
template <class Epi, class Sched, class Hook = NoHook>
DI void gemm_phase(LAS unsigned char* lds, const int pitchA, const int pitchB, const int nt, const Sched& S, const Epi& E, const Hook& H = Hook()) {
    const int tid = otid(), wid = __builtin_amdgcn_readfirstlane(tid >> 6), lane = tid & 63, wr = wid >> 2, wc = wid & 3, fr = lane & 15, fq = lane >> 4;
    unsigned voffA[2], voffB[2];
#pragma unroll
    for (int i = 0; i < 2; ++i) { int R, C; stage_rc(tid * 16 + i * 8192, R, C); voffA[i] = (unsigned)(R * pitchA + C) * 2u; voffB[i] = (unsigned)(R * pitchB + C) * 2u; }
    const size_t kstep = (size_t)(BK * 2);
    const size_t hstepA = (size_t)HALF * pitchA * 2, hstepB = (size_t)HALF * pitchB * 2;
    const unsigned ldsw = (unsigned)wid * 1024u;
    const int aoff = lds_byte(wr * 64 + fr, fq * 8), boff = lds_byte(wc * 32 + fr, fq * 8);
#define PG8_SA(b, h) (((b) * 2 + (h)) * HTB)
#define PG8_SB(b, h) ((4 + (b) * 2 + (h)) * HTB)
#define PG8_STAGE(bufoff, gbase, voff) do { _Pragma("unroll") for (int _i = 0; _i < 2; ++_i) \
        __builtin_amdgcn_global_load_lds((const unsigned*)((const char*)(gbase) + (voff)[_i]), (LAS unsigned*)(lds + (bufoff) + ldsw + _i * 8192), 16, 0, 0); } while (0)
#define PG8_LDA(dst, b, h) do { _Pragma("unroll") for (int m = 0; m < 4; ++m) _Pragma("unroll") for (int k = 0; k < 2; ++k) dst[m][k] = *(const LAS bf16x8*)(lds + PG8_SA(b, h) + aoff + m * 2048 + k * 1024); } while (0)
#define PG8_LDB(dst, b, h) do { _Pragma("unroll") for (int n = 0; n < 2; ++n) _Pragma("unroll") for (int k = 0; k < 2; ++k) dst[n][k] = *(const LAS bf16x8*)(lds + PG8_SB(b, h) + boff + n * 2048 + k * 1024); } while (0)
#define PG8_MMA(ai, bj, At, Bt) do { __builtin_amdgcn_s_setprio(1); _Pragma("unroll") for (int m = 0; m < 4; ++m) _Pragma("unroll") for (int n = 0; n < 2; ++n) _Pragma("unroll") for (int k = 0; k < 2; ++k) \
        acc[ai][bj][m][n] = __builtin_amdgcn_mfma_f32_16x16x32_bf16(Bt[n][k], At[m][k], acc[ai][bj][m][n], 0, 0, 0); __builtin_amdgcn_s_setprio(0); } while (0)
#define PG8_WAIT_V(n) asm volatile("s_waitcnt vmcnt(" #n ")" ::: "memory")
#define PG8_WAIT_L(n) asm volatile("s_waitcnt lgkmcnt(" #n ")" ::: "memory")
#define PG8_BAR __builtin_amdgcn_s_barrier()
#define PG8_SCHED __builtin_amdgcn_sched_barrier(0)
    Unit cur, nxt; int ui = 0;
    if (!S.next(0, cur)) return;
    f32x4 acc[2][2][4][2];
#pragma unroll
    for (int a = 0; a < 2; ++a)
#pragma unroll
        for (int b = 0; b < 2; ++b)
#pragma unroll
            for (int m = 0; m < 4; ++m)
#pragma unroll
                for (int n = 0; n < 2; ++n) acc[a][b][m][n] = (f32x4){0.f, 0.f, 0.f, 0.f};
    bf16x8 At[4][2], B0[2][2], B1[2][2];
    const char* cA = cur.a; const char* cB = cur.b;
    PG8_STAGE(PG8_SB(0, 0), cB, voffB); PG8_STAGE(PG8_SB(0, 1), cB + hstepB, voffB); PG8_STAGE(PG8_SA(0, 0), cA, voffA); PG8_STAGE(PG8_SA(0, 1), cA + hstepA, voffA);
    if (wr == 1) PG8_BAR;
    PG8_WAIT_V(2); PG8_BAR;
    PG8_STAGE(PG8_SB(1, 0), cB + kstep, voffB); PG8_STAGE(PG8_SA(1, 0), cA + kstep, voffA); PG8_STAGE(PG8_SB(1, 1), cB + hstepB + kstep, voffB);
    PG8_WAIT_V(6); PG8_BAR;
    for (;;) {
        const bool has_next = S.next(ui + 1, nxt);
        const char* nA = has_next ? nxt.a : cA; const char* nB = has_next ? nxt.b : cB;
        for (int t = 0; t < nt; t += 2) {
            const bool last = (t == nt - 2);
            if constexpr (Hook::ENABLED) { if (t == 8 || t == 12) { int le = lane; asm volatile("" : "+v"(le)); H(acc, cur, t, wr, wc, le & 15, le >> 4); } }
            const char* a1 = cA + (size_t)(t + 1) * kstep;
            const char* a2 = last ? nA : cA + (size_t)(t + 2) * kstep; const char* b2 = last ? nB : cB + (size_t)(t + 2) * kstep;
            const char* a3 = a2 + kstep; const char* b3 = b2 + kstep;
            PG8_LDB(B0, 0, 0); PG8_LDB(B1, 0, 1); PG8_SCHED; PG8_LDA(At, 0, 0); PG8_STAGE(PG8_SA(1, 1), a1 + hstepA, voffA);
            PG8_WAIT_V(8); PG8_WAIT_L(0); PG8_BAR; PG8_MMA(0, 0, At, B0); PG8_MMA(0, 1, At, B1); PG8_BAR; PG8_SCHED;
            PG8_LDA(At, 0, 1); PG8_STAGE(PG8_SB(0, 0), b2, voffB); PG8_STAGE(PG8_SB(0, 1), b2 + hstepB, voffB); PG8_STAGE(PG8_SA(0, 0), a2, voffA);
            PG8_WAIT_V(8); PG8_WAIT_L(0); PG8_BAR; PG8_MMA(1, 0, At, B0); PG8_MMA(1, 1, At, B1); PG8_BAR; PG8_SCHED;
            PG8_LDB(B0, 1, 0); PG8_LDB(B1, 1, 1); PG8_SCHED; PG8_LDA(At, 1, 0); PG8_STAGE(PG8_SA(0, 1), a2 + hstepA, voffA);
            PG8_WAIT_V(8); PG8_WAIT_L(0); PG8_BAR; PG8_MMA(0, 0, At, B0); PG8_MMA(0, 1, At, B1); PG8_BAR; PG8_SCHED;
            PG8_LDA(At, 1, 1); PG8_STAGE(PG8_SB(1, 0), b3, voffB); PG8_STAGE(PG8_SB(1, 1), b3 + hstepB, voffB); PG8_STAGE(PG8_SA(1, 0), a3, voffA);
            PG8_WAIT_V(8); PG8_WAIT_L(0); PG8_BAR; PG8_MMA(1, 0, At, B0); PG8_MMA(1, 1, At, B1); PG8_BAR; PG8_SCHED;
        }
        if (wr == 0) PG8_BAR;
        { int le = lane; asm volatile("" : "+v"(le)); E(acc, cur, wr, wc, le & 15, le >> 4); }
        if (!has_next) break;
#pragma unroll
        for (int a = 0; a < 2; ++a)
#pragma unroll
            for (int b = 0; b < 2; ++b)
#pragma unroll
                for (int m = 0; m < 4; ++m)
#pragma unroll
                    for (int n = 0; n < 2; ++n) acc[a][b][m][n] = (f32x4){0.f, 0.f, 0.f, 0.f};
        cur = nxt; cA = nA; cB = nB; ++ui;
        if (wr == 1) PG8_BAR;
    }
    PG8_WAIT_V(0);
    PG8_BAR;
#undef PG8_SA
#undef PG8_SB
#undef PG8_STAGE
#undef PG8_LDA
#undef PG8_LDB
#undef PG8_MMA
#undef PG8_WAIT_V
#undef PG8_WAIT_L
#undef PG8_BAR
#undef PG8_SCHED
}
}
using pg8::Unit;

#define XB_TMO      128
#define XB_XCNT(j)  (256  + 64 * (j))
#define XB_XSUB(j)  (1280 + 64 * (j))
#define XB_XGEN(j)  (2304 + 64 * (j))
#define XB_TOP      3328
#define XB_TOPGEN   3392
#define XCD_BAR_WORDS 3456
#define XB_SPIN_CAP (1u << 20)
DI unsigned xb_ld(unsigned* p)              { return __hip_atomic_load(p, __ATOMIC_RELAXED, __HIP_MEMORY_SCOPE_AGENT); }
DI unsigned xb_add(unsigned* p, unsigned v) { return __hip_atomic_fetch_add(p, v, __ATOMIC_RELAXED, __HIP_MEMORY_SCOPE_AGENT); }
DI unsigned xb_xcc_id() { return (unsigned)__builtin_amdgcn_s_getreg((3 << 11) | 20) & 0xFu; }
#define XB_SPIN(cond, bar) do { unsigned _sp = 0; while (cond) { __builtin_amdgcn_s_sleep(1); \
    if ((++_sp & 255u) == 0u) { if (xb_ld(&(bar)[XB_TMO])) break; if (_sp > XB_SPIN_CAP) { atomicAdd(&(bar)[XB_TMO], 1u); break; } } } } while (0)
struct XcdBarrier { unsigned* bar; unsigned x; volatile LAS unsigned* st; };
DI XcdBarrier xcd_barrier_post(unsigned* bar, volatile LAS unsigned* st) {
    XcdBarrier b; b.bar = bar; b.x = xb_xcc_id(); b.st = st;
    if (threadIdx.x == 0) (void)xb_add(&bar[XB_XCNT(b.x)], 1u);
    return b;
}
DI void xcd_barrier_complete(unsigned* bar, unsigned x, unsigned& nloc, unsigned& nx) {
    const unsigned G = gridDim.x * gridDim.y * gridDim.z;
    unsigned sum, cnt, mine, sp = 0u;
    for (;;) {
        sum = 0u; cnt = 0u; mine = 0u;
#pragma unroll
        for (unsigned j = 0; j < 16; ++j) { const unsigned c = xb_ld(&bar[XB_XCNT(j)]); sum += c; cnt += (c > 0u) ? 1u : 0u; mine = (j == x) ? c : mine; }
        if (sum == G) break;
        __builtin_amdgcn_s_sleep(1);
        if ((++sp & 255u) == 0u) { if (xb_ld(&bar[XB_TMO])) break; if (sp > XB_SPIN_CAP) { atomicAdd(&bar[XB_TMO], 1u); break; } }
    }
    nloc = mine > 0u ? mine : 1u; nx = cnt > 0u ? cnt : 1u;
}
DI void xcd_barrier(const XcdBarrier& b) {
    asm volatile("s_waitcnt vmcnt(0)" ::: "memory");
    __syncthreads();
    if (threadIdx.x == 0) {
        unsigned* bar = b.bar;
        __builtin_amdgcn_s_waitcnt(0);
        unsigned nloc = b.st[0], nx = b.st[1];
        if (nloc == 0u) { xcd_barrier_complete(bar, b.x, nloc, nx); b.st[0] = nloc; b.st[1] = nx; }
        const unsigned old = xb_add(&bar[XB_XSUB(b.x)], 1u);
        const unsigned gen = old / nloc;
        if (old + 1u == (gen + 1u) * nloc) {
            __builtin_amdgcn_fence(__ATOMIC_RELEASE, "agent");
            asm volatile("s_waitcnt vmcnt(0)" ::: "memory");
            const unsigned og = xb_add(&bar[XB_TOP], 1u);
            const unsigned tg = og / nx;
            if (og + 1u == (tg + 1u) * nx) xb_add(&bar[XB_TOPGEN], 1u);
            else XB_SPIN(xb_ld(&bar[XB_TOPGEN]) == tg, bar);
            __builtin_amdgcn_fence(__ATOMIC_ACQUIRE, "agent");
            xb_add(&bar[XB_XGEN(b.x)], 1u);
            asm volatile("s_waitcnt vmcnt(0)" ::: "memory");
        } else {
            XB_SPIN(xb_ld(&bar[XB_XGEN(b.x)]) == gen, bar);
            __builtin_amdgcn_fence(__ATOMIC_ACQUIRE, "agent");
            asm volatile("s_waitcnt vmcnt(0)" ::: "memory");
        }
    }
    __syncthreads();
}

struct Args {
    const float* x_prompt; const float* x_sample; const float* cache_k; const float* cache_v; const float* c; const float* c_ctx;
    const float* norm_g; const float* w_ada; const float* b_ada; const float* w_in; const float* q_g; const float* k_g; const float* rpb;
    const float* w_fnet; const float* w_pool; const float* pool_scale; const float* p_a; const float* p_b; const float* p_c; const float* w_o;
    float* out; unsigned char* ws; int ph_lo, ph_hi;
};

typedef const __attribute__((address_space(4))) Args* KArgP;
DI Args load_args(KArgP p) {
    Args a;
    a.x_prompt = p->x_prompt; a.x_sample = p->x_sample; a.cache_k = p->cache_k; a.cache_v = p->cache_v; a.c = p->c; a.c_ctx = p->c_ctx;
    a.norm_g = p->norm_g; a.w_ada = p->w_ada; a.b_ada = p->b_ada; a.w_in = p->w_in; a.q_g = p->q_g; a.k_g = p->k_g; a.rpb = p->rpb;
    a.w_fnet = p->w_fnet; a.w_pool = p->w_pool; a.pool_scale = p->pool_scale; a.p_a = p->p_a; a.p_b = p->p_b; a.p_c = p->p_c; a.w_o = p->w_o;
    a.out = p->out; a.ws = p->ws; a.ph_lo = p->ph_lo; a.ph_hi = p->ph_hi;
    return a;
}

DI void ada_task(const Args& A, int task, int lane, bool direct) {
    float* adap = (float*)(A.ws + WS_ADAP);
    {
        const int ng = task % 48, kc = (task / 48) & 15, l = task / 768;
        const int k = kc * 64 + lane;
        float sv[5];
        { const float v = A.c_ctx[k]; sv[0] = v * sigmoidf_(v); }
#pragma unroll
        for (int j = 1; j < 5; ++j) { const float v = A.c[(j - 1) * 1024 + k]; sv[j] = v * sigmoidf_(v); }
        float acc[5] = {0.f, 0.f, 0.f, 0.f, 0.f};
        const float* wp = A.w_ada + ((size_t)l * 1024 + kc * 64) * 3072 + ng * 64 + lane;
#pragma unroll 16
        for (int kk = 0; kk < 64; ++kk) {
            const float w = __builtin_nontemporal_load(wp + (size_t)kk * 3072);
#pragma unroll
            for (int j = 0; j < 5; ++j) acc[j] += __shfl(sv[j], kk) * w;
        }
#pragma unroll
        for (int j = 0; j < 5; ++j) {
            if (direct) atomicAdd((float*)(A.ws + WS_ADA) + (size_t)(l * 5 + j) * 3072 + ng * 64 + lane, acc[j] + (kc == 0 ? A.b_ada[l * 3072 + ng * 64 + lane] : 0.f));
            else adap[((size_t)(kc * 2 + l) * 5 + j) * 3072 + ng * 64 + lane] = acc[j];
        }
    }
}

DI int prow(int L) { return (L & ~31) | (16 * ((L >> 2) & 1) + 4 * ((L >> 3) & 3) + (L & 3)); }
DI int pcol(int p) { return (p & ~31) | (8 * ((p >> 2) & 3) + 4 * ((p >> 4) & 1) + (p & 3)); }
DI int win_row(int n) {
    if (n < 1536) { const int pn = n >> 8, l = n & 255, wc = l >> 6, bj = (l >> 5) & 1, o = l & 31; return pn * 256 + 128 * bj + 32 * wc + o; }
    if (n < 2048) return n;
    if (n < 2304) return -1;
    if (n < 2560) return 2048 + (n - 2304);
    if (n < 2816) return -1;
    if (n < 3072) return 2560 + (n - 2816);
    return 2816 + (n - 3072);
}
template <bool WIN>
DI void transpose_task(const float* src, int K, int N, bf16_t* dst, int dp, int coloff, int wt, int lane) {
    const int nch = N >> 6; const int n = (wt % nch) * 64 + lane, kb = wt / nch;
    const int row0 = WIN ? win_row(n) : n;
    if (row0 < 0) return;
    const int row = prow(row0);
    const float* sp = src + (size_t)(kb * 64) * N + n;
    bf16_t* dq = dst + (size_t)row * dp + coloff + kb * 64;
#pragma unroll 4
    for (int k8 = 0; k8 < 8; ++k8) {
        float v[8];
#pragma unroll
        for (int i = 0; i < 8; ++i) v[i] = __builtin_nontemporal_load(sp + (size_t)(k8 * 8 + i) * N);
        *(u32x4*)(dq + k8 * 8) = pk8(v);
    }
}

DI void fold_pool_task(const Args& A, int task, int lane, LAS float* wl) {
    {
        const int k8 = task & 127, g = (task >> 7) & 3, l = task >> 9;
        const float* wi = A.w_in + (size_t)l * 1024 * INW + (size_t)(k8 * 8) * INW + 2560 + g * 64;
        const float* wp = A.w_pool + ((size_t)(l * 4 + g) * 64) * 64 + lane;
        float acc[8] = {0.f, 0.f, 0.f, 0.f, 0.f, 0.f, 0.f, 0.f};
        {
            float rw[8];
#pragma unroll
            for (int i = 0; i < 8; ++i) rw[i] = wi[(size_t)i * INW + lane];
#pragma unroll
            for (int i = 0; i < 8; ++i) wl[i * 64 + lane] = rw[i];
            asm volatile("" ::: "memory");
        }
#pragma unroll 16
        for (int cc = 0; cc < 64; ++cc) {
            const float p = wp[cc * 64];
#pragma unroll
            for (int i = 0; i < 8; ++i) acc[i] += wl[i * 64 + cc] * p;
        }
        asm volatile("" ::: "memory");
        const float sc = A.pool_scale[l * 256 + g * 64 + lane];
#pragma unroll
        for (int i = 0; i < 8; ++i) acc[i] *= sc;
        bf16_t* dst = (bf16_t*)(A.ws + WS_WIN + (size_t)l * WIN_L) + (size_t)(2304 + prow(g * 64 + lane)) * 1024 + k8 * 8;
        *(u32x4*)dst = pk8(acc);
    }
}

DI void mcs_task(const Args& A, int task, int lane, const LAS f32x2* tbl) {
    float* M = (float*)(A.ws + WS_MCS);
    {
        const int eg = task & 3, m = (task >> 2) & 255, l = task >> 10;
        const int g = m >> 6, n2 = m & 63, e = eg * 64 + lane;
        const float* wf = A.w_fnet + ((size_t)l * 256 + g * 64) * 256 + e;
        float ac = 0.f, as = 0.f;
#pragma unroll 8
        for (int k2 = 0; k2 < 64; ++k2) {
            const f32x2 cs_ = tbl[((n2 * k2) & 63) * 32];
            const float w = wf[(size_t)k2 * 256];
            ac += cs_.x * w; as += cs_.y * w;
        }
        M[((size_t)(l * 2 + 0) * 256 + m) * 256 + e] = ac;
        M[((size_t)(l * 2 + 1) * 256 + m) * 256 + e] = as;
    }
}

DI void dft_task(const Args& A, int task, const LAS f32x2* tbl) {
    bf16_t* DS = (bf16_t*)(A.ws + WS_DS); bf16_t* DP = (bf16_t*)(A.ws + WS_DP);
    const float ss = 1.0f / sqrtf(2048.0f * 64.0f), sp = 1.0f / 128.0f;
    {
        float cv[8], sv[8];
        if (task < 1024 * 256) {
            const int k1 = task >> 8, n0 = (task & 255) * 8;
#pragma unroll
            for (int i = 0; i < 8; ++i) { const f32x2 cs_ = tbl[(k1 * (n0 + i)) & 2047]; cv[i] = cs_.x * ss; sv[i] = -cs_.y * ss; }
            *(u32x4*)(DS + ((size_t)((n0 >> 9) * 1024 + k1)) * 512 + (n0 & 511)) = pk8(cv); *(u32x4*)(DS + ((size_t)((4 + (n0 >> 9)) * 1024 + k1)) * 512 + (n0 & 511)) = pk8(sv);
        } else {
            const int t2 = task - 1024 * 256; const int k1 = t2 >> 5, n0 = (t2 & 31) * 8;
#pragma unroll
            for (int i = 0; i < 8; ++i) { const f32x2 cs_ = tbl[((k1 * (n0 + i)) & 255) * 8]; cv[i] = cs_.x * sp; sv[i] = -cs_.y * sp; }
            *(u32x4*)(DP + (size_t)k1 * 512 + n0) = pk8(cv); *(u32x4*)(DP + (size_t)k1 * 512 + 256 + n0) = pk8(sv);
        }
    }
}

DI void cache_task(const Args& A, int task) {
    bf16_t* CK = (bf16_t*)(A.ws + WS_CK); bf16_t* CV = (bf16_t*)(A.ws + WS_CV);
    {
        const int which = task >> 17, i8 = (task & 131071) * 8;
        const float* s = (which ? A.cache_v : A.cache_k) + i8;
        const f32x4 a = __builtin_nontemporal_load((const f32x4*)s), b = __builtin_nontemporal_load((const f32x4*)(s + 4));
        u32x4 w; w.x = pk2(a[0], a[1]); w.y = pk2(a[2], a[3]); w.z = pk2(b[0], b[1]); w.w = pk2(b[2], b[3]);
        *(u32x4*)((which ? CV : CK) + i8) = w;
    }
}

DI void phase_a(const Args& A, bool direct, LAS unsigned char* lds) {
    const int tid = otid(), lane = tid & 63;
    LAS f32x2* tbl = (LAS f32x2*)lds;
    for (int i = tid; i < 2048; i += blockDim.x) { const float a = (float)i * (1.0f / 1024.0f); tbl[i] = (f32x2){cospif(a), sinpif(a)}; }
    __syncthreads();
    LAS float* wl = (LAS float*)(lds + 16384 + (tid >> 6) * 2048);
    const int gw = __builtin_amdgcn_readfirstlane((blockIdx.x * blockDim.x + tid) >> 6), GW = (gridDim.x * blockDim.x) >> 6;
    constexpr int N_ADA = 1536, N_FP = 1024, N_MCS = 2048, N_WIN = 2 * 1536, N_WO = 2 * 256, N_PA = 2 * 128, N_PB = 2 * 64, N_PC = 2 * 64, N_CACHE = 4096, N_DFT = 4224;
    constexpr int E0 = N_ADA, E1 = E0 + N_FP, E2 = E1 + N_MCS, E3 = E2 + N_WIN, E4 = E3 + N_WO, E5 = E4 + N_PA, E6 = E5 + N_PB, E7 = E6 + N_PC, E8 = E7 + N_CACHE, E9 = E8 + N_DFT;
    for (int id = gw; id < E9; id += GW) {
        if (id < E0) ada_task(A, id, lane, direct);
        else if (id < E1) fold_pool_task(A, id - E0, lane, wl);
        else if (id < E2) mcs_task(A, id - E1, lane, tbl);
        else if (id < E3) { const int w = id - E2, l = w / 1536; transpose_task<true>(A.w_in + (size_t)l * 1024 * INW, 1024, INW, (bf16_t*)(A.ws + WS_WIN + (size_t)l * WIN_L), 1024, 0, w % 1536, lane); }
        else if (id < E4) { const int w = id - E3, l = w / 256; transpose_task<false>(A.w_o + (size_t)l * 1024 * 1024, 1024, 1024, (bf16_t*)(A.ws + WS_WO) + (size_t)l * 1024 * 1024, 1024, 0, w % 256, lane); }
        else if (id < E5) { const int w = id - E4, l = w / 128; transpose_task<false>(A.p_a + (size_t)l * 512 * 1024, 512, 1024, (bf16_t*)(A.ws + WS_PT) + (size_t)l * 1024 * 1024, 1024, 0, w % 128, lane); }
        else if (id < E6) { const int w = id - E5, l = w / 64; transpose_task<false>(A.p_b + (size_t)l * 256 * 1024, 256, 1024, (bf16_t*)(A.ws + WS_PT) + (size_t)l * 1024 * 1024, 1024, 512, w % 64, lane); }
        else if (id < E7) { const int w = id - E6, l = w / 64; transpose_task<false>(A.p_c + (size_t)l * 256 * 1024, 256, 1024, (bf16_t*)(A.ws + WS_PT) + (size_t)l * 1024 * 1024, 1024, 768, w % 64, lane); }
        else if (id < E8) cache_task(A, (id - E7) * 64 + lane);
        else dft_task(A, (id - E8) * 64 + lane, tbl);
    }
}

DI void phase_b(const Args& A, LAS unsigned char* lds, bool direct) {
    const int tid = otid(), lane = tid & 63;
    const int gt = blockIdx.x * blockDim.x + tid, GT = gridDim.x * blockDim.x;
    const int gw = __builtin_amdgcn_readfirstlane(gt >> 6), GW = GT >> 6;
    const float* adap = (const float*)(A.ws + WS_ADAP); float* ada = (float*)(A.ws + WS_ADA);
    if (!direct) for (int i = gt; i < 2 * 5 * 3072; i += GT) {
        const int n = i % 3072, l = i / (5 * 3072);
        float s = A.b_ada[l * 3072 + n];
#pragma unroll
        for (int kc = 0; kc < 16; ++kc) s += adap[(size_t)kc * (2 * 5 * 3072) + i];
        ada[i] = s;
    }
    const float* M = (const float*)(A.ws + WS_MCS);
    LAS float* wl = (LAS float*)(lds + (tid >> 6) * 8192);
    for (int task = gw; task < 2048; task += GW) {
        const int k8 = task & 127, eg = (task >> 7) & 3, s = (task >> 9) & 1, l = task >> 10;
        const float* wi = A.w_in + (size_t)l * 1024 * INW + (size_t)(k8 * 8) * INW + 2048;
        const float* mp = M + ((size_t)(l * 2 + s) * 256) * 256 + eg * 64 + lane;
        f32x4 rw[8];
#pragma unroll
        for (int i = 0; i < 8; ++i) rw[i] = *(const f32x4*)(wi + (size_t)i * INW + lane * 4);
#pragma unroll
        for (int i = 0; i < 8; ++i) *(LAS f32x4*)(wl + i * 256 + lane * 4) = rw[i];
        asm volatile("" ::: "memory");
        float acc[8] = {0.f, 0.f, 0.f, 0.f, 0.f, 0.f, 0.f, 0.f};
#pragma unroll 16
        for (int m = 0; m < 256; ++m) {
            const float mv = mp[(size_t)m * 256];
#pragma unroll
            for (int i = 0; i < 8; ++i) acc[i] += wl[i * 256 + m] * mv;
        }
        asm volatile("" ::: "memory");
        bf16_t* dst = (bf16_t*)(A.ws + WS_WIN + (size_t)l * WIN_L) + (size_t)(5888 + s * 256 + prow(eg * 64 + lane)) * 1024 + k8 * 8;
        *(u32x4*)dst = pk8(acc);
    }
}

DI const float* x_row(const Args& A, int l, int t) {
    if (l == 0) return t < TP ? A.x_prompt + (size_t)t * 1024 : A.x_sample + (size_t)(t - TP) * 1024;
    return A.out + (size_t)t * 1024;
}
DI int cond_of(int t) { return t < TP ? 0 : 1 + ((t - TP) >> 11); }

DI void sw_tasks(const Args& A, int gw, int GW, int lane) {
    const float* ada = (const float*)(A.ws + WS_ADA);
    {
        float sh[5][16];
#pragma unroll
        for (int j = 0; j < 5; ++j)
#pragma unroll
            for (int q = 0; q < 4; ++q) { const f32x4 v = *(const f32x4*)(ada + (size_t)(5 + j) * 3072 + lane * 16 + q * 4); sh[j][4 * q] = v[0]; sh[j][4 * q + 1] = v[1]; sh[j][4 * q + 2] = v[2]; sh[j][4 * q + 3] = v[3]; }
        const bf16_t* W1 = (const bf16_t*)(A.ws + WS_WIN + WIN_L); float* SW = (float*)(A.ws + WS_SW);
        for (int n = gw; n < 6400; n += GW) {
            const u32x4 w0 = *(const u32x4*)(W1 + (size_t)n * 1024 + lane * 16), w1 = *(const u32x4*)(W1 + (size_t)n * 1024 + lane * 16 + 8);
            const float wv[16] = {bflo(w0.x), bfhi(w0.x), bflo(w0.y), bfhi(w0.y), bflo(w0.z), bfhi(w0.z), bflo(w0.w), bfhi(w0.w), bflo(w1.x), bfhi(w1.x), bflo(w1.y), bfhi(w1.y), bflo(w1.z), bfhi(w1.z), bflo(w1.w), bfhi(w1.w)};
#pragma unroll
            for (int j = 0; j < 5; ++j) {
                float a = 0.f;
#pragma unroll
                for (int q = 0; q < 16; ++q) a += sh[j][q] * wv[q];
#pragma unroll
                for (int o = 32; o >= 1; o >>= 1) a += __shfl_xor(a, o);
                if (lane == 0) SW[j * 6400 + n] = a;
            }
        }
    }
}

DI void phase_norm(const Args& A, int l, bool do_sw) {
    const int tid = otid(), lane = tid & 63;
    const int gw = __builtin_amdgcn_readfirstlane((blockIdx.x * blockDim.x + tid) >> 6), GW = (gridDim.x * blockDim.x) >> 6;
    const float* ada = (const float*)(A.ws + WS_ADA);
    if (l == 0 && do_sw) sw_tasks(A, gw, GW, lane);
    bf16_t* XH = (bf16_t*)(A.ws + WS_XH);
    for (int t0 = gw; t0 < T; t0 += 6 * GW) {
        f32x4 v[6][4]; float ss[6];
#pragma unroll
        for (int q = 0; q < 6; ++q) {
            const int t = min(t0 + q * GW, T - 1);
            const float* xr = x_row(A, l, t);
#pragma unroll
            for (int i = 0; i < 4; ++i) v[q][i] = *(const f32x4*)(xr + i * 256 + lane * 4);
        }
#pragma unroll
        for (int q = 0; q < 6; ++q) {
            float a = 0.f;
#pragma unroll
            for (int i = 0; i < 4; ++i) a += v[q][i][0] * v[q][i][0] + v[q][i][1] * v[q][i][1] + v[q][i][2] * v[q][i][2] + v[q][i][3] * v[q][i][3];
#pragma unroll
            for (int o = 32; o >= 1; o >>= 1) a += __shfl_xor(a, o);
            ss[q] = rsqrtf(a * (1.0f / 1024.0f) + EPS);
        }
#pragma unroll
        for (int q = 0; q < 6; ++q) {
            const int t = t0 + q * GW;
            if (t < T) {
                const int j = cond_of(t);
                const float* sh = ada + (size_t)(l * 5 + j) * 3072; const float* sc = sh + 1024;
#pragma unroll
                for (int i = 0; i < 4; ++i) {
                    const int c0 = i * 256 + lane * 4;
                    const f32x4 g = *(const f32x4*)(A.norm_g + l * 1024 + c0), s1 = *(const f32x4*)(sc + c0), s0 = *(const f32x4*)(sh + c0);
                    float o[4];
#pragma unroll
                    for (int e = 0; e < 4; ++e) o[e] = v[q][i][e] * ss[q] * g[e] * (1.0f + s1[e]) + s0[e];
                    u32x2 w; w.x = pk2(o[0], o[1]); w.y = pk2(o[2], o[3]);
                    *(u32x2*)(XH + (size_t)t * 1024 + c0) = w;
                }
            }
        }
    }
}

constexpr size_t TILE1K = 256ull * 1024 * 2;
struct InSched {
    const char* XH; const char* W; int c, G;
    DI bool next(int i, Unit& u) const {
        int pm, pnn;
        if (G == 256) { const int xcd = c & 7, slot = c >> 3, j = i * 32 + slot; if (j >= 150) return false; pnn = j / 6; pm = xcd * 6 + j % 6; }
        else { const int L = i * G + c; if (L >= 1200) return false; pm = L % 48; pnn = L / 48; }
        if (pnn < 23) { u.a = XH + (size_t)pm * TILE1K; u.b = W + (size_t)pnn * TILE1K; u.k0 = 0; u.k1 = pm; u.k2 = pnn; u.k3 = 0; }
        else { u.a = W + (size_t)pnn * TILE1K; u.b = XH + (size_t)pm * TILE1K; u.k0 = 1; u.k1 = pnn - 23; u.k2 = pm; u.k3 = 0; }
        return true;
    }
};
struct EpiIn {
    int l; int fused; unsigned char* ws; float* outk; const float* qg; const float* kg;
    DI void operator()(f32x4 (&acc)[2][2][4][2], const Unit& u, int wr, int wc, int fr, int fq) const {
        LAUNDER();
        bf16_t* const QB = (bf16_t*)(ws + WS_QB); bf16_t* const Gb = (bf16_t*)(ws + WS_G); bf16_t* const UC = (bf16_t*)(ws + WS_UC); bf16_t* const SG = (bf16_t*)(ws + WS_SG);
        bf16_t* const VTS = (bf16_t*)(ws + WS_VTS); bf16_t* const VTP = (bf16_t*)(ws + WS_VTP); const float* const rss = (const float*)(ws + WS_RSS); const float* const sw = (const float*)(ws + WS_SW);
        if (u.k0 == 0) {
            const int pm = u.k1, pn = u.k2;
            if (fused) {
                const float* swp = sw + (size_t)cond_of(256 * pm) * 6400 + 256 * pn + 32 * wc + 4 * fq;
                f32x4 sw4[2][2];
#pragma unroll
                for (int bj = 0; bj < 2; ++bj)
#pragma unroll
                    for (int n = 0; n < 2; ++n) sw4[bj][n] = *(const f32x4*)(swp + 128 * bj + 16 * n);
#pragma unroll
                for (int ai = 0; ai < 2; ++ai)
#pragma unroll
                    for (int m = 0; m < 4; ++m) {
                        const float rs = rsqrtf(rss[256 * pm + 128 * ai + 64 * wr + 16 * m + fr] * (1.0f / 1024.0f) + EPS);
#pragma unroll
                        for (int bj = 0; bj < 2; ++bj)
#pragma unroll
                            for (int n = 0; n < 2; ++n) acc[ai][bj][m][n] = acc[ai][bj][m][n] * rs + sw4[bj][n];
                    }
            }
#define VAL(ai, bj, m, n) (acc[ai][bj][m][n])
            if (pn < 6) {
                const int kind = pn >> 1, head = (pn & 1) * 4 + wc;
                bf16_t* buf = QB + (size_t)kind * ((size_t)T * 512);
                float* ob = outk + (size_t)(kind - 1) * (16ull * 2 * 8 * 256 * 64);
                const float* gp = kind == 0 ? qg : kg;
                const float qs = kind == 0 ? 0.125f * LOG2E : 1.0f;
                f32x4 gv[2][2];
#pragma unroll
                for (int bj = 0; bj < 2; ++bj)
#pragma unroll
                    for (int n = 0; n < 2; ++n) gv[bj][n] = kind < 2 ? *(const f32x4*)(gp + l * 64 + 32 * bj + 8 * fq + 4 * n) * qs : (f32x4){1.f, 1.f, 1.f, 1.f};
#pragma unroll
                for (int ai = 0; ai < 2; ++ai)
#pragma unroll
                    for (int m = 0; m < 4; ++m) {
                        const int r = 128 * ai + 64 * wr + 16 * m + fr; const int t = 256 * pm + r;
                        float rstd = 1.0f;
                        if (kind < 2) {
                            float ss = 0.f;
#pragma unroll
                            for (int bj = 0; bj < 2; ++bj)
#pragma unroll
                                for (int n = 0; n < 2; ++n) { const f32x4 v = VAL(ai, bj, m, n); ss += v[0] * v[0] + v[1] * v[1] + v[2] * v[2] + v[3] * v[3]; }
                            ss += __shfl_xor(ss, 16); ss += __shfl_xor(ss, 32);
                            rstd = rsqrtf(ss * (1.0f / 64.0f) + EPS);
                        }
#pragma unroll
                        for (int bj = 0; bj < 2; ++bj) {
                            const int d0 = 32 * bj + 8 * fq;
                            const f32x4 v0 = VAL(ai, bj, m, 0) * rstd * gv[bj][0], v1 = VAL(ai, bj, m, 1) * rstd * gv[bj][1];
                            u32x4 w; w.x = pk2(v0[0], v0[1]); w.y = pk2(v0[2], v0[3]); w.z = pk2(v1[0], v1[1]); w.w = pk2(v1[2], v1[3]);
                            *(u32x4*)(buf + (size_t)t * 512 + head * 64 + d0) = w;
                            if (kind >= 1 && pm < 16) { float* op = ob + ((size_t)((pm * 2 + l) * 8 + head) * 256 + r) * 64 + d0; *(f32x4*)op = v0; *(f32x4*)(op + 4) = v1; }
                        }
                    }
            } else {
                bf16_t* base; int ld, mode;
                if (pn < 9) { base = Gb + (pn - 6) * 256; ld = 1024; mode = 1; }
                else if (pn == 9) { base = UC; ld = 256; mode = 0; }
                else if (pn == 10) { base = Gb + 768; ld = 1024; mode = 1; }
                else {
                    bf16_t* tb = SG + ((size_t)(((pn - 11) >> 2) * 48 + pm) * 4 + ((pn - 11) & 3)) * 65536 + (size_t)((wr * 4 + wc) * 16 * 64 + fq * 16 + fr) * 8;
#pragma unroll
                    for (int ai = 0; ai < 2; ++ai)
#pragma unroll
                        for (int m = 0; m < 4; ++m)
#pragma unroll
                            for (int bj = 0; bj < 2; ++bj) {
                                float o[8];
#pragma unroll
                                for (int n = 0; n < 2; ++n) {
                                    const f32x4 v = VAL(ai, bj, m, n);
#pragma unroll
                                    for (int e = 0; e < 4; ++e) o[4 * n + e] = sigmoidf_(v[e]);
                                }
                                *(u32x4*)(tb + (size_t)(((ai * 4 + m) * 2 + bj) * 64) * 8) = pk8(o);
                            }
                    return;
                }
#pragma unroll
                for (int ai = 0; ai < 2; ++ai)
#pragma unroll
                    for (int m = 0; m < 4; ++m) {
                        const int r = 128 * ai + 64 * wr + 16 * m + fr;
                        bf16_t* rowp = base + (size_t)(256 * pm + r) * ld + 32 * wc + 8 * fq;
#pragma unroll
                        for (int bj = 0; bj < 2; ++bj) {
                            float o[8];
#pragma unroll
                            for (int n = 0; n < 2; ++n) {
                                const f32x4 v = VAL(ai, bj, m, n);
#pragma unroll
                                for (int e = 0; e < 4; ++e) { const float s = sigmoidf_(v[e]); o[4 * n + e] = mode == 0 ? v[e] : v[e] * s; }
                            }
                            *(u32x4*)(rowp + 128 * bj) = pk8(o);
                        }
                    }
            }
#undef VAL
        } else {
            const int s = u.k1, pt = u.k2;
            bf16_t* base;
            if (pt < 16) base = VTP + (size_t)pt * 256 * 512 + s * 256;
            else { const int ts0 = 256 * (pt - 16), b = ts0 >> 11, n10 = ts0 & 2047; base = VTS + ((size_t)(b * 8 + s * 4 + (n10 >> 9)) * 256) * 512 + (n10 & 511); }
            f32x4 rs4[2][2];
#pragma unroll
            for (int bj = 0; bj < 2; ++bj)
#pragma unroll
                for (int n = 0; n < 2; ++n) {
                    rs4[bj][n] = (f32x4){1.f, 1.f, 1.f, 1.f};
                    if (fused) { const f32x4 q = *(const f32x4*)(rss + 256 * pt + 128 * bj + 32 * wc + 16 * n + 4 * fq);
                        rs4[bj][n] = (f32x4){rsqrtf(q[0] * (1.0f / 1024.0f) + EPS), rsqrtf(q[1] * (1.0f / 1024.0f) + EPS), rsqrtf(q[2] * (1.0f / 1024.0f) + EPS), rsqrtf(q[3] * (1.0f / 1024.0f) + EPS)}; }
                }
            const float* swp = sw + (size_t)cond_of(256 * pt) * 6400 + 5888 + 256 * s;
#pragma unroll
            for (int ai = 0; ai < 2; ++ai)
#pragma unroll
                for (int m = 0; m < 4; ++m) {
                    const int r = 128 * ai + 64 * wr + 16 * m + fr;
                    const float swr = fused ? swp[r] : 0.f;
                    bf16_t* rowp = base + (size_t)r * 512 + 32 * wc + 4 * fq;
#pragma unroll
                    for (int bj = 0; bj < 2; ++bj)
#pragma unroll
                        for (int n = 0; n < 2; ++n) {
                            const f32x4 v = fused ? acc[ai][bj][m][n] * rs4[bj][n] + swr : acc[ai][bj][m][n];
                            u32x2 w; w.x = pk2(v[0], v[1]); w.y = pk2(v[2], v[3]);
                            *(u32x2*)(rowp + 128 * bj + 16 * n) = w;
                        }
                }
        }
    }
};

struct FourSched {
    const char* DS; const char* DP; const char* VTS; const char* VTP; int c, G;
    DI bool next(int i, Unit& u) const {
        const int f = i * G + c; if (f >= 144) return false;
        if (f < 128) { const int b = f >> 5, pm = (f >> 3) & 3, kc = f & 7;
            u.a = DS + ((size_t)(kc * 1024 + pm * 256) * 512) * 2; u.b = VTS + ((size_t)(b * 8 + kc) * 256 * 512) * 2; u.k0 = 0; u.k1 = b; u.k2 = pm; u.k3 = kc; }
        else { const int b = f - 128; u.a = DP; u.b = VTP + (size_t)b * 256 * 512 * 2; u.k0 = 1; u.k1 = b; u.k2 = 0; u.k3 = 0; }
        return true;
    }
};
struct EpiFour {
    bf16_t* YS; bf16_t* YP;
    DI void operator()(const f32x4 (&acc)[2][2][4][2], const Unit& u, int wr, int wc, int fr, int fq) const {
        LAUNDER();
        bf16_t* base = u.k0 == 0 ? YS + ((size_t)u.k3 * 8192 + u.k1 * 2048 + u.k2 * 256) * 256 : YP + (size_t)u.k1 * 256 * 256;
#pragma unroll
        for (int ai = 0; ai < 2; ++ai)
#pragma unroll
            for (int m = 0; m < 4; ++m) {
                const int r = 128 * ai + 64 * wr + 16 * m + fr;
                bf16_t* rowp = base + (size_t)r * 256 + 32 * wc + 8 * fq;
#pragma unroll
                for (int bj = 0; bj < 2; ++bj) {
                    const f32x4 v0 = acc[ai][bj][m][0], v1 = acc[ai][bj][m][1];
                    u32x4 w; w.x = pk2(v0[0], v0[1]); w.y = pk2(v0[2], v0[3]); w.z = pk2(v1[0], v1[1]); w.w = pk2(v1[2], v1[3]);
                    *(u32x4*)(rowp + 128 * bj) = w;
                }
            }
    }
};

DI int crow(int i, int hf) { return (i & 3) + 8 * (i >> 2) + 4 * hf; }
DI s16x4 tr_read(const LAS unsigned char* p) { return __builtin_bit_cast(s16x4, __builtin_amdgcn_ds_read_tr16_b64_v4i16((LAS s16x4*)p)); }

constexpr int VROW = 144, PBUF = 64 * VROW, STG = 2 * PBUF;
constexpr int RPB_LDS = 15360;

DI void attn_wg(const Args& A, int l, int kind, int b, int h, int r4, LAS unsigned char* lds, int wid, int lane, int tid, int dry) {
    const bf16_t* QB = (const bf16_t*)(A.ws + WS_QB); const bf16_t* KB = (const bf16_t*)(A.ws + WS_KB); const bf16_t* VB = (const bf16_t*)(A.ws + WS_VB);
    const bf16_t* CK = (const bf16_t*)(A.ws + WS_CK); const bf16_t* CV = (const bf16_t*)(A.ws + WS_CV);
    bf16_t* Gb = (bf16_t*)(A.ws + WS_G);
    const LAS float* rpbL = (const LAS float*)lds + 64 + h * 465;
    LAS unsigned char* sb = lds + RPB_LDS;
    const int r = lane & 31, hf = lane >> 5;
    int qtok, npair, rs = 0, rsU = 0, grow = 0, hq = 0;
    if (kind == 0) {
        grow = r4 * 4 + (wid >> 1); hq = wid & 1; qtok = TP + b * 2048 + grow * 64 + hq * 32 + r;
        rs = min(max(grow - 4, 0), 24); rsU = min(max(r4 * 4 - 4, 0), 24);
        const int rsL = min(max(r4 * 4 + 3 - 4, 0), 24);
        npair = 4 + (rsL + 8 - rsU);
    } else { qtok = b * 256 + wid * 32 + r; npair = 4; }
    const int qc = hq * 32 + r, cs = min(max(qc - 8, 0), 48);
    bf16x8 qf[4];
#pragma unroll
    for (int s = 0; s < 4; ++s) qf[s] = *(const bf16x8*)(QB + (size_t)qtok * 512 + h * 64 + 16 * s + 8 * hf);
    f32x16 o0, o1;
#pragma unroll
    for (int i = 0; i < 16; ++i) { o0[i] = 0.f; o1[i] = 0.f; }
    float mrun = -1e30f, lrun = 0.f;
    auto pair_ptrs = [&](int pi, const bf16_t*& kp, const bf16_t*& vp, int& pitch) {
        if (kind == 0) {
            if (pi < 4) { const size_t off = ((size_t)((b * 2 + l) * 8 + h) * 256 + 64 * pi) * 64; kp = CK + off; vp = CV + off; pitch = 64; }
            else { const size_t off = (size_t)(TP + b * 2048 + (rsU + pi - 4) * 64) * 512 + h * 64; kp = KB + off; vp = VB + off; pitch = 512; }
        } else { const size_t off = (size_t)(b * 256 + 64 * pi) * 512 + h * 64; kp = KB + off; vp = VB + off; pitch = 512; }
    };
    const int lrow = tid >> 3, lc16 = tid & 7;
    const int ldst = lrow * VROW + lc16 * 16;
    u32x4 kR[3], vR[3];
#define ATT_LOAD(J, P) do { if ((P) < npair) { const bf16_t* kp_; const bf16_t* vp_; int pitch_; pair_ptrs((P), kp_, vp_, pitch_); \
        kR[J] = *(const u32x4*)(kp_ + (size_t)lrow * pitch_ + lc16 * 8); vR[J] = *(const u32x4*)(vp_ + (size_t)lrow * pitch_ + lc16 * 8); } } while (0)
    ATT_LOAD(0, 0); ATT_LOAD(1, 1); ATT_LOAD(2, 2);
    __syncthreads();
    *(LAS u32x4*)(sb + ldst) = kR[0]; *(LAS u32x4*)(sb + PBUF + ldst) = vR[0];
    __syncthreads();
    for (int pi0 = 0; pi0 < npair; pi0 += 3) {
#pragma unroll
      for (int jj = 0; jj < 3; ++jj) {
        const int pi = pi0 + jj;
        if (pi < npair) {
        const bool more = pi + 1 < npair;
        if (jj == 0) ATT_LOAD(0, pi + 3); else if (jj == 1) ATT_LOAD(1, pi + 3); else ATT_LOAD(2, pi + 3);
        const int wrow = rsU + pi - 4;
        const bool mine = (kind != 0) || pi < 4 || (wrow >= rs && wrow < rs + 8);
        if (mine) {
            const LAS unsigned char* kb_ = sb + (pi & 1) * STG;
            const LAS unsigned char* vb_ = kb_ + PBUF;
            bf16x8 kf[2][4];
#pragma unroll
            for (int u = 0; u < 2; ++u)
#pragma unroll
                for (int s = 0; s < 4; ++s) kf[u][s] = *(const LAS bf16x8*)(kb_ + (32 * u + r) * VROW + (16 * s + 8 * hf) * 2);
            f32x16 x0, x1;
#pragma unroll
            for (int i = 0; i < 16; ++i) { x0[i] = 0.f; x1[i] = 0.f; }
#pragma unroll
            for (int s = 0; s < 4; ++s) { x0 = __builtin_amdgcn_mfma_f32_32x32x16_bf16(kf[0][s], qf[s], x0, 0, 0, 0); x1 = __builtin_amdgcn_mfma_f32_32x32x16_bf16(kf[1][s], qf[s], x1, 0, 0, 0); }
            const bool win = (kind == 0 && pi >= 4);
            bool lv[2][4];
#pragma unroll
            for (int g = 0; g < 4; ++g) { lv[0][g] = !win || hq == 0 || g == 3; lv[1][g] = !win || hq == 1 || g == 0; }
            if (win) {
                const int ridx = wrow - grow + 7;
                int csl = cs - 4 * hf, bl = 4 * hf - qc + 15;
                asm volatile("" : "+v"(csl), "+v"(bl));
                const LAS float* rp = rpbL + ridx * 31 + bl;
#pragma unroll
                for (int g = 0; g < 4; ++g) {
                    if (lv[0][g]) {
#pragma unroll
                        for (int jx = 0; jx < 4; ++jx) { const int i = 4 * g + jx, ci = jx + 8 * g; const bool valid = (unsigned)(ci - csl) < 16u; const float bias = rp[ci]; x0[i] = valid ? x0[i] + bias : -1e30f; }
                    }
                    if (lv[1][g]) {
#pragma unroll
                        for (int jx = 0; jx < 4; ++jx) { const int i = 4 * g + jx, ci = jx + 8 * g; const bool valid = (unsigned)(ci + 32 - csl) < 16u; const float bias = rp[ci + 32]; x1[i] = valid ? x1[i] + bias : -1e30f; }
                    }
                }
            }
            float mx = -1e30f;
#pragma unroll
            for (int g = 0; g < 4; ++g) {
                if (lv[0][g]) mx = fmaxf(fmaxf(mx, fmaxf(x0[4 * g], x0[4 * g + 1])), fmaxf(x0[4 * g + 2], x0[4 * g + 3]));
                if (lv[1][g]) mx = fmaxf(fmaxf(mx, fmaxf(x1[4 * g], x1[4 * g + 1])), fmaxf(x1[4 * g + 2], x1[4 * g + 3]));
            }
            mx = fmaxf(mx, __shfl_xor(mx, 32));
            const float mnew = fmaxf(mrun, mx);
            const float alpha = __builtin_amdgcn_exp2f(mrun - mnew);
            float psum = 0.f;
#pragma unroll
            for (int g = 0; g < 4; ++g) {
                if (lv[0][g]) {
#pragma unroll
                    for (int jx = 0; jx < 4; ++jx) { const int i = 4 * g + jx; x0[i] = __builtin_amdgcn_exp2f(x0[i] - mnew); psum += x0[i]; }
                } else {
#pragma unroll
                    for (int jx = 0; jx < 4; ++jx) x0[4 * g + jx] = 0.f;
                }
                if (lv[1][g]) {
#pragma unroll
                    for (int jx = 0; jx < 4; ++jx) { const int i = 4 * g + jx; x1[i] = __builtin_amdgcn_exp2f(x1[i] - mnew); psum += x1[i]; }
                } else {
#pragma unroll
                    for (int jx = 0; jx < 4; ++jx) x1[4 * g + jx] = 0.f;
                }
            }
            lrun = lrun * alpha + psum; mrun = mnew;
#pragma unroll
            for (int i = 0; i < 16; ++i) { o0[i] *= alpha; o1[i] *= alpha; }
            const int q4 = (lane & 15) >> 2, p4 = lane & 3, blk = (lane >> 4) & 1;
#pragma unroll
            for (int u = 0; u < 2; ++u) {
                const LAS unsigned char* vcur = vb_ + (32 * u + 4 * hf + q4) * VROW + (16 * blk + 4 * p4) * 2;
#pragma unroll
                for (int s2 = 0; s2 < 2; ++s2) {
                    if (lv[u][2 * s2] || lv[u][2 * s2 + 1]) {
                        s16x4 lo[2], hi[2];
#pragma unroll
                        for (int db = 0; db < 2; ++db) { lo[db] = tr_read(vcur + (16 * s2) * VROW + 64 * db); hi[db] = tr_read(vcur + (16 * s2 + 8) * VROW + 64 * db); }
                        u32x4 pw;
                        if (u == 0) { pw.x = pk2(x0[8 * s2 + 0], x0[8 * s2 + 1]); pw.y = pk2(x0[8 * s2 + 2], x0[8 * s2 + 3]); pw.z = pk2(x0[8 * s2 + 4], x0[8 * s2 + 5]); pw.w = pk2(x0[8 * s2 + 6], x0[8 * s2 + 7]); }
                        else        { pw.x = pk2(x1[8 * s2 + 0], x1[8 * s2 + 1]); pw.y = pk2(x1[8 * s2 + 2], x1[8 * s2 + 3]); pw.z = pk2(x1[8 * s2 + 4], x1[8 * s2 + 5]); pw.w = pk2(x1[8 * s2 + 6], x1[8 * s2 + 7]); }
                        const bf16x8 pb = __builtin_bit_cast(bf16x8, pw);
                        const bf16x8 va0 = __builtin_shufflevector(lo[0], hi[0], 0, 1, 2, 3, 4, 5, 6, 7);
                        const bf16x8 va1 = __builtin_shufflevector(lo[1], hi[1], 0, 1, 2, 3, 4, 5, 6, 7);
                        o0 = __builtin_amdgcn_mfma_f32_32x32x16_bf16(va0, pb, o0, 0, 0, 0);
                        o1 = __builtin_amdgcn_mfma_f32_32x32x16_bf16(va1, pb, o1, 0, 0, 0);
                    }
                }
            }
        }
        if (more) {
            LAS unsigned char* nb = sb + ((pi + 1) & 1) * STG;
            const int jn = (jj + 1) % 3;
            *(LAS u32x4*)(nb + ldst) = kR[jn]; *(LAS u32x4*)(nb + PBUF + ldst) = vR[jn];
        }
        __syncthreads();
        }
      }
    }
#undef ATT_LOAD
    const float ltot = lrun + __shfl_xor(lrun, 32);
    const float inv = 1.0f / ltot;
    bf16_t* zrow = Gb + (size_t)qtok * 1024 + h * 64;
    u32x2 z[2][4];
#pragma unroll
    for (int db = 0; db < 2; ++db)
#pragma unroll
        for (int g = 0; g < 4; ++g) z[db][g] = *(const u32x2*)(zrow + 32 * db + 8 * g + 4 * hf);
#pragma unroll
    for (int db = 0; db < 2; ++db)
#pragma unroll
        for (int g = 0; g < 4; ++g) {
            const int d0 = 32 * db + 8 * g + 4 * hf;
            float ov[4];
#pragma unroll
            for (int j = 0; j < 4; ++j) ov[j] = (db == 0 ? o0[4 * g + j] : o1[4 * g + j]) * inv;
            u32x2 w; w.x = pk2(ov[0] * bflo(z[db][g].x), ov[1] * bfhi(z[db][g].x)); w.y = pk2(ov[2] * bflo(z[db][g].y), ov[3] * bfhi(z[db][g].y));
            if (!dry) *(u32x2*)(zrow + d0) = w;
        }
}

DI void pool_tasks(const Args& A, int gt, int GT, int dry) {
    const bf16_t* UC = (const bf16_t*)(A.ws + WS_UC); bf16_t* ZC = (bf16_t*)(A.ws + WS_G) + 768;
    for (int task = gt; task < T * 32; task += GT) {
        const int g = __builtin_amdgcn_readfirstlane(task / (T * 8)), rem = task - g * (T * 8), t = rem >> 3, c0 = g * 64 + (rem & 7) * 8, half = 1 << g;
        int tb, pos, L;
        if (t < TP) { tb = t & ~255; pos = t & 255; L = 256; } else { const int ts = t - TP; tb = TP + (ts & ~2047); pos = ts & 2047; L = 2048; }
        const int lo = max(pos - half, 0), hi = min(pos + half, L);
        float sum[8] = {0.f, 0.f, 0.f, 0.f, 0.f, 0.f, 0.f, 0.f};
#pragma unroll
        for (int j = 0; j < 16; ++j) {
            if (j >= 2 * half) break;
            const int p = lo + j; const bool ok = p < hi;
            const u32x4 w = *(const u32x4*)(UC + (size_t)(tb + (ok ? p : pos)) * 256 + c0);
            if (ok) { sum[0] += bflo(w.x); sum[1] += bfhi(w.x); sum[2] += bflo(w.y); sum[3] += bfhi(w.y); sum[4] += bflo(w.z); sum[5] += bfhi(w.z); sum[6] += bflo(w.w); sum[7] += bfhi(w.w); }
        }
        const float inv = __builtin_amdgcn_rcpf((float)(hi - lo));
        const u32x4 sf = *(const u32x4*)(UC + (size_t)t * 256 + c0);
        const u32x4 z = *(const u32x4*)(ZC + (size_t)t * 1024 + c0);
        const float s[8] = {bflo(sf.x), bfhi(sf.x), bflo(sf.y), bfhi(sf.y), bflo(sf.z), bfhi(sf.z), bflo(sf.w), bfhi(sf.w)};
        const float zz[8] = {bflo(z.x), bfhi(z.x), bflo(z.y), bfhi(z.y), bflo(z.z), bfhi(z.z), bflo(z.w), bfhi(z.w)};
        float o[8];
#pragma unroll
        for (int i = 0; i < 8; ++i) o[i] = zz[i] * (sum[i] * inv - s[i]);
        if (!dry) *(u32x4*)(ZC + (size_t)t * 1024 + c0) = pk8(o);
    }
}

DI void phase_mix(const Args& A, int l, LAS unsigned char* lds, int dry, int parts, bool sw_here) {
    const int tid = otid(), lane = tid & 63, wid = __builtin_amdgcn_readfirstlane(tid >> 6);
    const int c = blockIdx.x, G = gridDim.x;
    if (parts & 1) {
        FourSched S{(const char*)(A.ws + WS_DS), (const char*)(A.ws + WS_DP), (const char*)(A.ws + WS_VTS), (const char*)(A.ws + WS_VTP), c, G};
        EpiFour E{(bf16_t*)(A.ws + WS_XH), (bf16_t*)(A.ws + WS_XH) + 8ull * 8192 * 256};
        pg8::gemm_phase<EpiFour, FourSched>(lds, 512, 512, 8, S, E);
    }
    if (parts & 2) {
    for (int i = tid; i < 8 * 465; i += blockDim.x) ((LAS float*)lds)[64 + i] = A.rpb[(size_t)l * 8 * 465 + i] * LOG2E;
    __syncthreads();
    if (G == 256) {
        { const int wt = c; const int b = wt >> 6, h = (wt >> 3) & 7, r4 = wt & 7; attn_wg(A, l, 0, b, h, r4, lds, wid, lane, tid, dry); }
        if (c >= 144) {
            { const int m = c - 144; const int b = m >> 3, h = m & 7; attn_wg(A, l, 1, b, h, 0, lds, wid, lane, tid, dry); }
            const int r4c = c & 7; const int idx = r4c == 0 ? ((c - 144) >> 3) : (r4c == 7 ? 14 + ((c - 151) >> 3) : 99);
            if (idx < 16) { const int m = 112 + idx; const int b = m >> 3, h = m & 7; attn_wg(A, l, 1, b, h, 0, lds, wid, lane, tid, dry); }
        }
    } else
    for (int wt = c; wt < 384; wt += G) {
        if (wt < 256) { const int b = wt >> 6, h = (wt >> 3) & 7, r4 = wt & 7; attn_wg(A, l, 0, b, h, r4, lds, wid, lane, tid, dry); }
        else { const int m = wt - 256; const int b = m >> 3, h = m & 7; attn_wg(A, l, 1, b, h, 0, lds, wid, lane, tid, dry); }
    }
    }
    if (parts & 4) {
        {
            const bf16_t* VTS = (const bf16_t*)(A.ws + WS_VTS); float* Y1K = (float*)(A.ws + WS_Y1K);
            const int gw = __builtin_amdgcn_readfirstlane((blockIdx.x * blockDim.x + tid) >> 6), GW = (gridDim.x * blockDim.x) >> 6;
            for (int task = gw; task < 1024; task += GW) {
                const int b = task >> 8, e = task & 255;
                const bf16_t* row = VTS + ((size_t)(b * 8 + (lane >> 4)) * 256 + e) * 512 + (lane & 15) * 32;
                float a = 0.f;
#pragma unroll
                for (int q = 0; q < 4; ++q) { const u32x4 w = *(const u32x4*)(row + q * 8);
                    a += (bflo(w.x) - bfhi(w.x)) + (bflo(w.y) - bfhi(w.y)) + (bflo(w.z) - bfhi(w.z)) + (bflo(w.w) - bfhi(w.w)); }
#pragma unroll
                for (int o = 32; o >= 1; o >>= 1) a += __shfl_xor(a, o);
                if (lane == 0 && !dry) Y1K[(task & ~255) + pcol(e)] = a * (1.0f / sqrtf(2048.0f * 64.0f));
            }
        }
        pool_tasks(A, blockIdx.x * blockDim.x + tid, gridDim.x * blockDim.x, dry);
        if (sw_here && !dry) { const int gw2 = __builtin_amdgcn_readfirstlane((blockIdx.x * blockDim.x + tid) >> 6); sw_tasks(A, gw2, (gridDim.x * blockDim.x) >> 6, lane); }
    }
    __syncthreads();
}

DI void phase_gb(const Args& A, int dry) {
    const int gt = blockIdx.x * blockDim.x + otid(), GT = gridDim.x * blockDim.x;
    const bf16_t* YS = (const bf16_t*)(A.ws + WS_XH); const bf16_t* YP = YS + 8ull * 8192 * 256; bf16_t* ZB = (bf16_t*)(A.ws + WS_G) + 512;
    for (int task = gt; task < T * 32; task += GT) {
        const int tt = task >> 5, c0 = (task & 31) * 8;
        const int t = tt < TS ? TP + tt : tt - TS;
        float s[8] = {0.f, 0.f, 0.f, 0.f, 0.f, 0.f, 0.f, 0.f};
        const u32x4 z = *(const u32x4*)(ZB + (size_t)t * 1024 + c0);
        if (t < TP) {
            const u32x4 w = *(const u32x4*)(YP + (size_t)t * 256 + c0);
            s[0] = bflo(w.x); s[1] = bfhi(w.x); s[2] = bflo(w.y); s[3] = bfhi(w.y); s[4] = bflo(w.z); s[5] = bfhi(w.z); s[6] = bflo(w.w); s[7] = bfhi(w.w);
        } else {
            const int ts = t - TP, k1 = ts & 2047;
            if (k1 == 1024) {
                const float* y = (const float*)(A.ws + WS_Y1K) + (ts >> 11) * 256 + c0;
                const f32x4 y0 = *(const f32x4*)y, y1 = *(const f32x4*)(y + 4);
                s[0] = y0[0]; s[1] = y0[1]; s[2] = y0[2]; s[3] = y0[3]; s[4] = y1[0]; s[5] = y1[1]; s[6] = y1[2]; s[7] = y1[3];
            } else {
                const int src = (ts & ~2047) + (k1 < 1024 ? k1 : 2048 - k1);
                const float sg = k1 < 1024 ? 1.0f : -1.0f;
                u32x4 w[8];
#pragma unroll
                for (int kc = 0; kc < 8; ++kc) w[kc] = (k1 > 1024) ? __builtin_nontemporal_load((const u32x4*)(YS + ((size_t)kc * 8192 + src) * 256 + c0)) : *(const u32x4*)(YS + ((size_t)kc * 8192 + src) * 256 + c0);
#pragma unroll
                for (int kc = 0; kc < 8; ++kc) { const float f = kc < 4 ? 1.0f : sg;
                    s[0] += f * bflo(w[kc].x); s[1] += f * bfhi(w[kc].x); s[2] += f * bflo(w[kc].y); s[3] += f * bfhi(w[kc].y); s[4] += f * bflo(w[kc].z); s[5] += f * bfhi(w[kc].z); s[6] += f * bflo(w[kc].w); s[7] += f * bfhi(w[kc].w); }
            }
        }
        float o[8] = {s[0] * bflo(z.x), s[1] * bfhi(z.x), s[2] * bflo(z.y), s[3] * bfhi(z.y), s[4] * bflo(z.z), s[5] * bfhi(z.z), s[6] * bflo(z.w), s[7] * bfhi(z.w)};
        if (!dry) *(u32x4*)(ZB + (size_t)t * 1024 + c0) = pk8(o);
    }
}

struct TileSched {
    const char* Ab; const char* Bb; size_t tileA, tileB; int c, G;
    DI bool next(int i, Unit& u) const { const int f = i * G + c; if (f >= 192) return false; const int pm = f >> 2, pn = f & 3; u.a = Ab + pm * tileA; u.b = Bb + pn * tileB; u.k0 = 0; u.k1 = pm; u.k2 = pn; u.k3 = 0; return true; }
};
struct HookProj {
    static constexpr bool ENABLED = true;
    const bf16_t* SG;
    DI void operator()(f32x4 (&acc)[2][2][4][2], const Unit& u, int t, int wr, int wc, int fr, int fq) const {
        LAUNDER();
        const size_t GT_ = (size_t)48 * 4 * 65536;
        const bf16_t* sp = SG + (t == 8 ? (size_t)0 : GT_) + ((size_t)u.k1 * 4 + u.k2) * 65536 + (size_t)((wr * 4 + wc) * 16 * 64 + fq * 16 + fr) * 8;
#pragma unroll
        for (int ai = 0; ai < 2; ++ai) {
            u32x4 gn[8], gd[8];
#pragma unroll
            for (int q = 0; q < 8; ++q) { gn[q] = __builtin_nontemporal_load((const u32x4*)(sp + (size_t)((ai * 8 + q) * 64) * 8)); gd[q] = *(const u32x4*)(sp + GT_ + (size_t)((ai * 8 + q) * 64) * 8); }
#pragma unroll
            for (int m = 0; m < 4; ++m)
#pragma unroll
                for (int bj = 0; bj < 2; ++bj) {
                    const u32x4 a = gn[m * 2 + bj], d = gd[m * 2 + bj];
                    f32x4 v0 = acc[ai][bj][m][0], v1 = acc[ai][bj][m][1];
                    v0[0] *= bflo(a.x) * __builtin_amdgcn_rcpf(fmaxf(bflo(d.x), 1e-30f)); v0[1] *= bfhi(a.x) * __builtin_amdgcn_rcpf(fmaxf(bfhi(d.x), 1e-30f));
                    v0[2] *= bflo(a.y) * __builtin_amdgcn_rcpf(fmaxf(bflo(d.y), 1e-30f)); v0[3] *= bfhi(a.y) * __builtin_amdgcn_rcpf(fmaxf(bfhi(d.y), 1e-30f));
                    v1[0] *= bflo(a.z) * __builtin_amdgcn_rcpf(fmaxf(bflo(d.z), 1e-30f)); v1[1] *= bfhi(a.z) * __builtin_amdgcn_rcpf(fmaxf(bfhi(d.z), 1e-30f));
                    v1[2] *= bflo(a.w) * __builtin_amdgcn_rcpf(fmaxf(bflo(d.w), 1e-30f)); v1[3] *= bfhi(a.w) * __builtin_amdgcn_rcpf(fmaxf(bfhi(d.w), 1e-30f));
                    acc[ai][bj][m][0] = v0; acc[ai][bj][m][1] = v1;
                }
        }
    }
};
struct EpiProj {
    const bf16_t* SGc; bf16_t* MG;
    DI void operator()(const f32x4 (&acc)[2][2][4][2], const Unit& u, int wr, int wc, int fr, int fq) const {
        LAUNDER();
        const bf16_t* sp = SGc + ((size_t)u.k1 * 4 + u.k2) * 65536 + (size_t)((wr * 4 + wc) * 16 * 64 + fq * 16 + fr) * 8;
#pragma unroll
        for (int ai = 0; ai < 2; ++ai) {
            u32x4 gc[8];
#pragma unroll
            for (int q = 0; q < 8; ++q) gc[q] = __builtin_nontemporal_load((const u32x4*)(sp + (size_t)((ai * 8 + q) * 64) * 8));
#pragma unroll
            for (int m = 0; m < 4; ++m) {
                const int t = 256 * u.k1 + 128 * ai + 64 * wr + 16 * m + fr;
                bf16_t* rowp = MG + (size_t)t * 1024 + 256 * u.k2 + 32 * wc + 8 * fq;
#pragma unroll
                for (int bj = 0; bj < 2; ++bj) {
                    const u32x4 g = gc[m * 2 + bj];
                    const f32x4 v0 = acc[ai][bj][m][0], v1 = acc[ai][bj][m][1];
                    u32x2 w0; w0.x = pk2(v0[0] * bflo(g.x), v0[1] * bfhi(g.x)); w0.y = pk2(v0[2] * bflo(g.y), v0[3] * bfhi(g.y));
                    u32x2 w1; w1.x = pk2(v1[0] * bflo(g.z), v1[1] * bfhi(g.z)); w1.y = pk2(v1[2] * bflo(g.w), v1[3] * bfhi(g.w));
                    u32x4 w01; w01.x = w0.x; w01.y = w0.y; w01.z = w1.x; w01.w = w1.y; *(u32x4*)(rowp + 128 * bj) = w01;
                }
            }
        }
    }
};
struct EpiOut {
    const float* xp; const float* xs; float* out; const float* ng1; int l; const float* ada; int dry; bf16_t* XG; float* rss;
    DI void operator()(const f32x4 (&acc)[2][2][4][2], const Unit& u, int wr, int wc, int fr, int fq) const {
        LAUNDER();
        const int t0 = 256 * u.k1; const int j = cond_of(t0);
        const int cb = 256 * u.k2 + 32 * wc + 8 * fq;
        const float* gate = ada + (size_t)(l * 5 + j) * 3072 + 2048 + cb;
        f32x4 gv[2][2], gm[2][2];
#pragma unroll
        for (int bj = 0; bj < 2; ++bj)
#pragma unroll
            for (int n = 0; n < 2; ++n) {
                gv[bj][n] = *(const f32x4*)(gate + 128 * bj + 4 * n);
                gm[bj][n] = (f32x4){0.f, 0.f, 0.f, 0.f};
                if (XG) gm[bj][n] = *(const f32x4*)(ng1 + cb + 128 * bj + 4 * n) * (*(const f32x4*)(ada + (size_t)(5 + j) * 3072 + 1024 + cb + 128 * bj + 4 * n) + 1.0f);
            }
#pragma unroll
        for (int ai = 0; ai < 2; ++ai)
#pragma unroll
            for (int mh = 0; mh < 2; ++mh) {
                f32x4 xv[2][2][2];
#pragma unroll
                for (int mm = 0; mm < 2; ++mm) {
                    const int t = t0 + 128 * ai + 64 * wr + 16 * (2 * mh + mm) + fr;
                    const float* xr = (l == 0 ? (t < TP ? xp + (size_t)t * 1024 : xs + (size_t)(t - TP) * 1024) : out + (size_t)t * 1024) + cb;
#pragma unroll
                    for (int bj = 0; bj < 2; ++bj)
#pragma unroll
                        for (int n = 0; n < 2; ++n) xv[mm][bj][n] = *(const f32x4*)(xr + 128 * bj + 4 * n);
                }
#pragma unroll
                for (int mm = 0; mm < 2; ++mm) {
                    const int m = 2 * mh + mm;
                    const int t = t0 + 128 * ai + 64 * wr + 16 * m + fr;
                    float* orow = out + (size_t)t * 1024 + cb;
                    float ssq = 0.f;
#pragma unroll
                    for (int bj = 0; bj < 2; ++bj) {
                        const f32x4 xn0 = xv[mm][bj][0] + gv[bj][0] * acc[ai][bj][m][0], xn1 = xv[mm][bj][1] + gv[bj][1] * acc[ai][bj][m][1];
                        if (!dry) { *(f32x4*)(orow + 128 * bj) = xn0; *(f32x4*)(orow + 128 * bj + 4) = xn1; }
                        if (XG) {
                            const f32x4 y0 = xn0 * gm[bj][0], y1 = xn1 * gm[bj][1];
                            u32x4 w; w.x = pk2(y0[0], y0[1]); w.y = pk2(y0[2], y0[3]); w.z = pk2(y1[0], y1[1]); w.w = pk2(y1[2], y1[3]);
                            if (!dry) *(u32x4*)(XG + (size_t)t * 1024 + cb + 128 * bj) = w;
                            ssq += xn0[0] * xn0[0] + xn0[1] * xn0[1] + xn0[2] * xn0[2] + xn0[3] * xn0[3] + xn1[0] * xn1[0] + xn1[1] * xn1[1] + xn1[2] * xn1[2] + xn1[3] * xn1[3];
                        }
                    }
                    if (XG) {
                        ssq += __shfl_xor(ssq, 16); ssq += __shfl_xor(ssq, 32);
                        if (fq == 0 && !dry) atomicAdd(rss + t, ssq);
                    }
                }
            }
    }
};

__global__ void __launch_bounds__(512, 2) mk_fwd(Args A0) {
    const Args& A = A0;
    extern __shared__ __attribute__((aligned(16))) unsigned char lds_raw[];
    LAS unsigned char* lds = (LAS unsigned char*)lds_raw;
    cg::grid_group grid = cg::this_grid();
    const int lo = A.ph_lo, hi = A.ph_hi;
    if (threadIdx.x < 4) ((LAS unsigned*)(lds + LDS_RING))[threadIdx.x] = 0u;
    __syncthreads();
    XcdBarrier xbar = xcd_barrier_post((unsigned*)(A.ws + WS_BAR), (volatile LAS unsigned*)(lds + LDS_RING));
    if (hi > 1000) grid.sync();
    const int c = blockIdx.x, G = gridDim.x;
    const bool fuse1 = (lo == 0 && hi == 14);
#define IN(k) (lo <= (k) && (k) < hi)
#define SEAM(k) do { if (IN(k) && IN((k) + 1)) xcd_barrier(xbar); } while (0)
#if defined(PROBE_PHASE)
#define NREPS(k) (((k) == PROBE_PHASE) ? 1 + PROBE_REPS : 1)
#else
#define NREPS(k) 1
#endif
#if defined(PROBE_PARTS)
#define PARTS(dry) ((dry) ? PROBE_PARTS : 7)
#else
#define PARTS(dry) 7
#endif
#define PHASE(k, ...) do { if (IN(k)) { const int nreps_ = NREPS(k); for (int rep_ = 0; rep_ < nreps_; ++rep_) { const int dry = rep_ > 0; (void)dry; if (rep_ > 0) xcd_barrier(xbar); \
        KArgP ap_ = (KArgP)__builtin_amdgcn_kernarg_segment_ptr(); asm volatile("" : "+s"(ap_)); \
        const Args& A = *(const Args*)ap_;     \
        __VA_ARGS__ } } SEAM(k); } while (0)
#if defined(PROBE_A_REPS)
    for (int r = 0; r < PROBE_A_REPS; ++r) phase_a(A, fuse1, lds);
#endif
    PHASE(0, phase_a(A, fuse1, lds););
#if defined(PROBE_SYNCS)
    for (int r = 0; r < PROBE_SYNCS; ++r) xcd_barrier(xbar);
#endif
    PHASE(1, { phase_b(A, lds, fuse1); if (fuse1) phase_norm(A, 0, false); });
    for (int l = 0; l < 2; ++l) {
        const int p0 = 2 + 6 * l;
        if (!fuse1) PHASE(p0, phase_norm(A, l, true););
        PHASE(p0 + 1, {
            InSched S{(const char*)(A.ws + WS_XH), (const char*)(A.ws + WS_WIN + (size_t)l * WIN_L), c, G};
            EpiIn E{l, (l == 1 && fuse1) ? 1 : 0, A.ws, A.out + (size_t)T * 1024, A.q_g, A.k_g};
            pg8::gemm_phase<EpiIn, InSched>(lds, 1024, 1024, 16, S, E);
        });
        PHASE(p0 + 2, phase_mix(A, l, lds, dry, PARTS(dry), fuse1 && l == 0););
        PHASE(p0 + 3, phase_gb(A, dry););
        PHASE(p0 + 4, {
            const bf16_t* SG = (const bf16_t*)(A.ws + WS_SG);
            TileSched S{(const char*)(A.ws + WS_G), (const char*)(A.ws + WS_PT + (size_t)l * 1024 * 1024 * 2), TILE1K, TILE1K, c, G};
            EpiProj E{SG + 2 * (size_t)48 * 4 * 65536, (bf16_t*)(A.ws + WS_QB)};
            HookProj H{SG};
            pg8::gemm_phase<EpiProj, TileSched, HookProj>(lds, 1024, 1024, 16, S, E, H);
        });
        PHASE(p0 + 5, {
            TileSched S{(const char*)(A.ws + WS_QB), (const char*)(A.ws + WS_WO + (size_t)l * 1024 * 1024 * 2), TILE1K, TILE1K, c, G};
            EpiOut E{A.x_prompt, A.x_sample, A.out, A.norm_g + 1024, l, (const float*)(A.ws + WS_ADA), dry, (l == 0 && fuse1) ? (bf16_t*)(A.ws + WS_XH) : (bf16_t*)nullptr, (float*)(A.ws + WS_RSS)};
            pg8::gemm_phase<EpiOut, TileSched>(lds, 1024, 1024, 16, S, E);
        });
    }
#undef IN
#undef SEAM
}

extern "C" void kernel_launch(void* const* d_in, const int* in_sizes, int n_in, void* d_out, int out_size, void* d_ws, size_t ws_size, hipStream_t stream) {
    static int grid = 0;
    if (grid == 0) {
        if (ws_size < WS_END) { fprintf(stderr, "kernel_launch: workspace too small: %zu < %zu\n", ws_size, (size_t)WS_END); grid = -1; return; }
        int dev = 0, cus = 0, per_cu = 0;
        hipGetDevice(&dev);
        hipDeviceGetAttribute(&cus, hipDeviceAttributeMultiprocessorCount, dev);
        if (hipFuncSetAttribute((const void*)mk_fwd, hipFuncAttributeMaxDynamicSharedMemorySize, LDS_BYTES) != hipSuccess) { fprintf(stderr, "kernel_launch: hipFuncSetAttribute failed\n"); grid = -1; return; }
        hipOccupancyMaxActiveBlocksPerMultiprocessor(&per_cu, (const void*)mk_fwd, 512, LDS_BYTES);
        (void)hipGetLastError();
        if (per_cu < 1) per_cu = 1;
        grid = cus;
        if (grid <= 0) grid = 256;
    }
    if (grid < 0) return;
    Args a{};
    a.x_prompt = (const float*)d_in[0]; a.x_sample = (const float*)d_in[1]; a.cache_k = (const float*)d_in[2]; a.cache_v = (const float*)d_in[3];
    a.c = (const float*)d_in[4]; a.c_ctx = (const float*)d_in[5]; a.norm_g = (const float*)d_in[6]; a.w_ada = (const float*)d_in[7]; a.b_ada = (const float*)d_in[8];
    a.w_in = (const float*)d_in[9]; a.q_g = (const float*)d_in[10]; a.k_g = (const float*)d_in[11]; a.rpb = (const float*)d_in[12]; a.w_fnet = (const float*)d_in[13];
    a.w_pool = (const float*)d_in[14]; a.pool_scale = (const float*)d_in[15]; a.p_a = (const float*)d_in[16]; a.p_b = (const float*)d_in[17]; a.p_c = (const float*)d_in[18]; a.w_o = (const float*)d_in[19];
    a.out = (float*)d_out; a.ws = (unsigned char*)d_ws;
#if MK_SINGLE
    if (hipMemsetAsync((char*)d_ws + WS_BAR, 0, ZERO_BYTES, stream) != hipSuccess) { fprintf(stderr, "kernel_launch: memset of the barrier words failed\n"); return; }
    if (hipMemsetAsync((char*)d_ws + WS_ADA, 0, 2ull * 5 * 3072 * 4, stream) != hipSuccess) { fprintf(stderr, "kernel_launch: memset of ADA failed\n"); return; }
    a.ph_lo = 0; a.ph_hi = 14;
    void* args[] = {&a};
    hipError_t e = hipLaunchCooperativeKernel((const void*)mk_fwd, dim3(grid), dim3(512), args, LDS_BYTES, stream);
    if (e != hipSuccess) fprintf(stderr, "cooperative launch failed: %s (grid %d)\n", hipGetErrorString(e), grid);
#else
    for (int p = 0; p < 14; ++p) {
        a.ph_lo = p; a.ph_hi = p + 1;
        hipLaunchKernelGGL(mk_fwd, dim3(grid), dim3(512), LDS_BYTES, stream, a);
    }
#endif
}
```

```cpp
#include <hip/hip_runtime.h>
#include <hip/hip_cooperative_groups.h>
#include <cstdio>
#include <cstdint>
namespace cg = cooperative_groups;

#ifndef MK_SINGLE
#define MK_SINGLE 1
#endif

#define LAS __attribute__((address_space(3)))
typedef unsigned short bf16_t;
typedef short bf16x8 __attribute__((ext_vector_type(8)));
typedef short s16x4 __attribute__((ext_vector_type(4)));
typedef float f32x2 __attribute__((ext_vector_type(2)));
typedef float f32x4 __attribute__((ext_vector_type(4)));
typedef float f32x16 __attribute__((ext_vector_type(16)));
typedef unsigned u32x2 __attribute__((ext_vector_type(2)));
typedef unsigned u32x4 __attribute__((ext_vector_type(4)));
typedef __bf16 bf16x2_t __attribute__((ext_vector_type(2)));

#define DI __device__ __forceinline__
#define LAUNDER() asm volatile("" : "+v"(fr), "+v"(fq), "+s"(wr), "+s"(wc))

DI int otid() { int t = threadIdx.x; asm volatile("" : "+v"(t)); return t; }
DI unsigned pk2(float lo, float hi) { f32x2 v = {lo, hi}; bf16x2_t b = __builtin_convertvector(v, bf16x2_t); return __builtin_bit_cast(unsigned, b); }
DI float bflo(unsigned w) { return __uint_as_float(w << 16); }
DI float bfhi(unsigned w) { return __uint_as_float(w & 0xffff0000u); }
DI u32x4 pk8(const float* v) { u32x4 w; w.x = pk2(v[0], v[1]); w.y = pk2(v[2], v[3]); w.z = pk2(v[4], v[5]); w.w = pk2(v[6], v[7]); return w; }
DI float sigmoidf_(float v) { return __builtin_amdgcn_rcpf(1.0f + __builtin_amdgcn_exp2f(-1.4426950408889634f * v)); }

constexpr int T = 12288, TP = 4096, TS = 8192, DM = 1024, INW = 6144;
constexpr float LOG2E = 1.4426950408889634f;
constexpr float EPS = 1e-6f;

constexpr size_t WS_ADAP = 0;
constexpr size_t WS_ADA  = WS_ADAP + 16ull * 2 * 5 * 3072 * 4;
constexpr size_t WS_MCS  = WS_ADA + 2ull * 5 * 3072 * 4;
constexpr size_t WS_WIN  = WS_MCS + 2ull * 2 * 256 * 256 * 4;
constexpr size_t WIN_L   = 6400ull * 1024 * 2;
constexpr size_t WS_PT   = WS_WIN + 2 * WIN_L;
constexpr size_t WS_WO   = WS_PT + 2ull * 1024 * 1024 * 2;
constexpr size_t WS_DS   = WS_WO + 2ull * 1024 * 1024 * 2;
constexpr size_t WS_DP   = WS_DS + 2048ull * 4096 * 2;
constexpr size_t WS_CK   = WS_DP + 256ull * 4096 * 2;
constexpr size_t WS_CV   = WS_CK + 4ull * 2 * 8 * 256 * 64 * 2;
constexpr size_t WS_XH   = WS_CV + 4ull * 2 * 8 * 256 * 64 * 2;
constexpr size_t YBP_BYTES = 8ull * 8192 * 256 * 2 + 4096ull * 256 * 2;
constexpr size_t WS_QB   = WS_XH + YBP_BYTES;
constexpr size_t WS_KB   = WS_QB + (size_t)T * 512 * 2;
constexpr size_t WS_VB   = WS_KB + (size_t)T * 512 * 2;
constexpr size_t WS_VTS  = WS_VB + (size_t)T * 512 * 2;
constexpr size_t WS_VTP  = WS_VTS + 2ull * 256 * 8192 * 2;
constexpr size_t WS_G    = WS_VTP + 256ull * 8192 * 2;
constexpr size_t WS_UC   = WS_G + (size_t)T * 1024 * 2;
constexpr size_t WS_SG   = WS_UC + (size_t)T * 256 * 2;
constexpr size_t WS_BAR  = WS_SG + 3ull * T * 1024 * 2;
constexpr size_t WS_RSS  = WS_BAR + 16384;
constexpr size_t WS_SW   = WS_RSS + (size_t)T * 4;
constexpr size_t WS_Y1K  = WS_SW + 5ull * 6400 * 4;
constexpr size_t WS_END  = WS_Y1K + 4ull * 256 * 4;
constexpr size_t ZERO_BYTES = 16384 + (size_t)T * 4;
static_assert(WS_END <= 268435456ull, "workspace");

constexpr int LDS_RING = 131072;
constexpr int LDS_BYTES = LDS_RING + 16;

namespace pg8 {
constexpr int BM = 256, BK = 64, HALF = 128, HTB = HALF * BK * 2;
DI int lds_byte(int r, int c) { const int st = (r >> 4) * 2 + (c >> 5), rr = r & 15, cc = c & 31, ob = rr * 64 + cc * 2; return st * 1024 + (ob ^ (((ob >> 9) & 1) << 5)); }
DI void stage_rc(int b, int& R, int& C) { const int st = b / 1024, sb = b % 1024, swz = sb ^ (((sb >> 9) & 1) << 5); R = (st >> 1) * 16 + swz / 64; C = (st & 1) * 32 + (swz % 64) / 2; }
struct Unit { const char* a; const char* b; int k0, k1, k2, k3; };

struct NoHook { static constexpr bool ENABLED = false; DI void operator()(f32x4 (&)[2][2][4][2], const Unit&, int, int, int, int, int) const {} };
template <class Epi, class Sched, class Hook = NoHook>
DI void gemm_phase(LAS unsigned char* lds, const int pitchA, const int pitchB, const int nt, const Sched& S, const Epi& E, const Hook& H = Hook()) {
    const int tid = otid(), wid = __builtin_amdgcn_readfirstlane(tid >> 6), lane = tid & 63, wr = wid >> 2, wc = wid & 3, fr = lane & 15, fq = lane >> 4;
    unsigned voffA[2], voffB[2];
#pragma unroll
    for (int i = 0; i < 2; ++i) { int R, C; stage_rc(tid * 16 + i * 8192, R, C); voffA[i] = (unsigned)(R * pitchA + C) * 2u; voffB[i] = (unsigned)(R * pitchB + C) * 2u; }
    const size_t kstep = (size_t)(BK * 2);
    const size_t hstepA = (size_t)HALF * pitchA * 2, hstepB = (size_t)HALF * pitchB * 2;
    const unsigned ldsw = (unsigned)wid * 1024u;
    const int aoff = lds_byte(wr * 64 + fr, fq * 8), boff = lds_byte(wc * 32 + fr, fq * 8);
#define PG8_SA(b, h) (((b) * 2 + (h)) * HTB)
#define PG8_SB(b, h) ((4 + (b) * 2 + (h)) * HTB)
#define PG8_STAGE(bufoff, gbase, voff) do { _Pragma("unroll") for (int _i = 0; _i < 2; ++_i) \
        __builtin_amdgcn_global_load_lds((const unsigned*)((const char*)(gbase) + (voff)[_i]), (LAS unsigned*)(lds + (bufoff) + ldsw + _i * 8192), 16, 0, 0); } while (0)
#define PG8_LDA(dst, b, h) do { _Pragma("unroll") for (int m = 0; m < 4; ++m) _Pragma("unroll") for (int k = 0; k < 2; ++k) dst[m][k] = *(const LAS bf16x8*)(lds + PG8_SA(b, h) + aoff + m * 2048 + k * 1024); } while (0)
#define PG8_LDB(dst, b, h) do { _Pragma("unroll") for (int n = 0; n < 2; ++n) _Pragma("unroll") for (int k = 0; k < 2; ++k) dst[n][k] = *(const LAS bf16x8*)(lds + PG8_SB(b, h) + boff + n * 2048 + k * 1024); } while (0)
#define PG8_MMA(ai, bj, At, Bt) do { __builtin_amdgcn_s_setprio(1); _Pragma("unroll") for (int m = 0; m < 4; ++m) _Pragma("unroll") for (int n = 0; n < 2; ++n) _Pragma("unroll") for (int k = 0; k < 2; ++k) \
        acc[ai][bj][m][n] = __builtin_amdgcn_mfma_f32_16x16x32_bf16(Bt[n][k], At[m][k], acc[ai][bj][m][n], 0, 0, 0); __builtin_amdgcn_s_setprio(0); } while (0)
#define PG8_WAIT_V(n) asm volatile("s_waitcnt vmcnt(" #n ")" ::: "memory")
#define PG8_WAIT_L(n) asm volatile("s_waitcnt lgkmcnt(" #n ")" ::: "memory")
#define PG8_BAR __builtin_amdgcn_s_barrier()
#define PG8_SCHED __builtin_amdgcn_sched_barrier(0)
    Unit cur, nxt; int ui = 0;
    if (!S.next(0, cur)) return;
    f32x4 acc[2][2][4][2];
#pragma unroll
    for (int a = 0; a < 2; ++a)
#pragma unroll
        for (int b = 0; b < 2; ++b)
#pragma unroll
            for (int m = 0; m < 4; ++m)
#pragma unroll
                for (int n = 0; n < 2; ++n) acc[a][b][m][n] = (f32x4){0.f, 0.f, 0.f, 0.f};
    bf16x8 At[4][2], B0[2][2], B1[2][2];
    const char* cA = cur.a; const char* cB = cur.b;
    PG8_STAGE(PG8_SB(0, 0), cB, voffB); PG8_STAGE(PG8_SB(0, 1), cB + hstepB, voffB); PG8_STAGE(PG8_SA(0, 0), cA, voffA); PG8_STAGE(PG8_SA(0, 1), cA + hstepA, voffA);
    if (wr == 1) PG8_BAR;
    PG8_WAIT_V(2); PG8_BAR;
    PG8_STAGE(PG8_SB(1, 0), cB + kstep, voffB); PG8_STAGE(PG8_SA(1, 0), cA + kstep, voffA); PG8_STAGE(PG8_SB(1, 1), cB + hstepB + kstep, voffB);
    PG8_WAIT_V(6); PG8_BAR;
    for (;;) {
        const bool has_next = S.next(ui + 1, nxt);
        const char* nA = has_next ? nxt.a : cA; const char* nB = has_next ? nxt.b : cB;
        for (int t = 0; t < nt; t += 2) {
            const bool last = (t == nt - 2);
            if constexpr (Hook::ENABLED) { if (t == 8 || t == 12) { int le = lane; asm volatile("" : "+v"(le)); H(acc, cur, t, wr, wc, le & 15, le >> 4); } }
            const char* a1 = cA + (size_t)(t + 1) * kstep;
            const char* a2 = last ? nA : cA + (size_t)(t + 2) * kstep; const char* b2 = last ? nB : cB + (size_t)(t + 2) * kstep;
            const char* a3 = a2 + kstep; const char* b3 = b2 + kstep;
            PG8_LDB(B0, 0, 0); PG8_LDB(B1, 0, 1); PG8_SCHED; PG8_LDA(At, 0, 0); PG8_STAGE(PG8_SA(1, 1), a1 + hstepA, voffA);
            PG8_WAIT_V(8); PG8_WAIT_L(0); PG8_BAR; PG8_MMA(0, 0, At, B0); PG8_MMA(0, 1, At, B1); PG8_BAR; PG8_SCHED;
            PG8_LDA(At, 0, 1); PG8_STAGE(PG8_SB(0, 0), b2, voffB); PG8_STAGE(PG8_SB(0, 1), b2 + hstepB, voffB); PG8_STAGE(PG8_SA(0, 0), a2, voffA);
            PG8_WAIT_V(8); PG8_WAIT_L(0); PG8_BAR; PG8_MMA(1, 0, At, B0); PG8_MMA(1, 1, At, B1); PG8_BAR; PG8_SCHED;
            PG8_LDB(B0, 1, 0); PG8_LDB(B1, 1, 1); PG8_SCHED; PG8_LDA(At, 1, 0); PG8_STAGE(PG8_SA(0, 1), a2 + hstepA, voffA);
            PG8_WAIT_V(8); PG8_WAIT_L(0); PG8_BAR; PG8_MMA(0, 0, At, B0); PG8_MMA(0, 1, At, B1); PG8_BAR; PG8_SCHED;
            PG8_LDA(At, 1, 1); PG8_STAGE(PG8_SB(1, 0), b3, voffB); PG8_STAGE(PG8_SB(1, 1), b3 + hstepB, voffB); PG8_STAGE(PG8_SA(1, 0), a3, voffA);
            PG8_WAIT_V(8); PG8_WAIT_L(0); PG8_BAR; PG8_MMA(1, 0, At, B0); PG8_MMA(1, 1, At, B1); PG8_BAR; PG8_SCHED;
        }
        if (wr == 0) PG8_BAR;
        { int le = lane; asm volatile("" : "+v"(le)); E(acc, cur, wr, wc, le & 15, le >> 4); }
        if (!has_next) break;
#pragma unroll
        for (int a = 0; a < 2; ++a)
#pragma unroll
            for (int b = 0; b < 2; ++b)
#pragma unroll
                for (int m = 0; m < 4; ++m)
#pragma unroll
                    for (int n = 0; n < 2; ++n) acc[a][b][m][n] = (f32x4){0.f, 0.f, 0.f, 0.f};
        cur = nxt; cA = nA; cB = nB; ++ui;
        if (wr == 1) PG8_BAR;
    }
    PG8_WAIT_V(0);
    PG8_BAR;
#undef PG8_SA
#undef PG8_SB
#undef PG8_STAGE
#undef PG8_LDA
#undef PG8_LDB
#undef PG8_MMA
#undef PG8_WAIT_V
#undef PG8_WAIT_L
#undef PG8_BAR
#undef PG8_SCHED
}
}
using pg8::Unit;

#define XB_TMO      128
#define XB_XCNT(j)  (256  + 64 * (j))
#define XB_XSUB(j)  (1280 + 64 * (j))
#define XB_XGEN(j)  (2304 + 64 * (j))
#define XB_TOP      3328
#define XB_TOPGEN   3392
#define XCD_BAR_WORDS 3456
#define XB_SPIN_CAP (1u << 20)
DI unsigned xb_ld(unsigned* p)              { return __hip_atomic_load(p, __ATOMIC_RELAXED, __HIP_MEMORY_SCOPE_AGENT); }
DI unsigned xb_add(unsigned* p, unsigned v) { return __hip_atomic_fetch_add(p, v, __ATOMIC_RELAXED, __HIP_MEMORY_SCOPE_AGENT); }
DI unsigned xb_xcc_id() { return (unsigned)__builtin_amdgcn_s_getreg((3 << 11) | 20) & 0xFu; }
#define XB_SPIN(cond, bar) do { unsigned _sp = 0; while (cond) { __builtin_amdgcn_s_sleep(1); \
    if ((++_sp & 255u) == 0u) { if (xb_ld(&(bar)[XB_TMO])) break; if (_sp > XB_SPIN_CAP) { atomicAdd(&(bar)[XB_TMO], 1u); break; } } } } while (0)
struct XcdBarrier { unsigned* bar; unsigned x; volatile LAS unsigned* st; };
DI XcdBarrier xcd_barrier_post(unsigned* bar, volatile LAS unsigned* st) {
    XcdBarrier b; b.bar = bar; b.x = xb_xcc_id(); b.st = st;
    if (threadIdx.x == 0) (void)xb_add(&bar[XB_XCNT(b.x)], 1u);
    return b;
}
DI void xcd_barrier_complete(unsigned* bar, unsigned x, unsigned& nloc, unsigned& nx) {
    const unsigned G = gridDim.x * gridDim.y * gridDim.z;
    unsigned sum, cnt, mine, sp = 0u;
    for (;;) {
        sum = 0u; cnt = 0u; mine = 0u;
#pragma unroll
        for (unsigned j = 0; j < 16; ++j) { const unsigned c = xb_ld(&bar[XB_XCNT(j)]); sum += c; cnt += (c > 0u) ? 1u : 0u; mine = (j == x) ? c : mine; }
        if (sum == G) break;
        __builtin_amdgcn_s_sleep(1);
        if ((++sp & 255u) == 0u) { if (xb_ld(&bar[XB_TMO])) break; if (sp > XB_SPIN_CAP) { atomicAdd(&bar[XB_TMO], 1u); break; } }
    }
    nloc = mine > 0u ? mine : 1u; nx = cnt > 0u ? cnt : 1u;
}
DI void xcd_barrier(const XcdBarrier& b) {
    asm volatile("s_waitcnt vmcnt(0)" ::: "memory");
    __syncthreads();
    if (threadIdx.x == 0) {
        unsigned* bar = b.bar;
        __builtin_amdgcn_s_waitcnt(0);
        unsigned nloc = b.st[0], nx = b.st[1];
        if (nloc == 0u) { xcd_barrier_complete(bar, b.x, nloc, nx); b.st[0] = nloc; b.st[1] = nx; }
        const unsigned old = xb_add(&bar[XB_XSUB(b.x)], 1u);
        const unsigned gen = old / nloc;
        if (old + 1u == (gen + 1u) * nloc) {
            __builtin_amdgcn_fence(__ATOMIC_RELEASE, "agent");
            asm volatile("s_waitcnt vmcnt(0)" ::: "memory");
            const unsigned og = xb_add(&bar[XB_TOP], 1u);
            const unsigned tg = og / nx;
            if (og + 1u == (tg + 1u) * nx) xb_add(&bar[XB_TOPGEN], 1u);
            else XB_SPIN(xb_ld(&bar[XB_TOPGEN]) == tg, bar);
            __builtin_amdgcn_fence(__ATOMIC_ACQUIRE, "agent");
            xb_add(&bar[XB_XGEN(b.x)], 1u);
            asm volatile("s_waitcnt vmcnt(0)" ::: "memory");
        } else {
            XB_SPIN(xb_ld(&bar[XB_XGEN(b.x)]) == gen, bar);
            __builtin_amdgcn_fence(__ATOMIC_ACQUIRE, "agent");
            asm volatile("s_waitcnt vmcnt(0)" ::: "memory");
        }
    }
    __syncthreads();
}

struct Args {
    const float* x_prompt; const float* x_sample; const float* cache_k; const float* cache_v; const float* c; const float* c_ctx;
    const float* norm_g; const float* w_ada; const float* b_ada; const float* w_in; const float* q_g; const float* k_g; const float* rpb;
    const float* w_fnet; const float* w_pool; const float* pool_scale; const float* p_a; const float* p_b; const float* p_c; const float* w_o;
    float* out; unsigned char* ws; int ph_lo, ph_hi;
};

typedef const __attribute__((address_space(4))) Args* KArgP;
DI Args load_args(KArgP p) {
    Args a;
    a.x_prompt = p->x_prompt; a.x_sample = p->x_sample; a.cache_k = p->cache_k; a.cache_v = p->cache_v; a.c = p->c; a.c_ctx = p->c_ctx;
    a.norm_g = p->norm_g; a.w_ada = p->w_ada; a.b_ada = p->b_ada; a.w_in = p->w_in; a.q_g = p->q_g; a.k_g = p->k_g; a.rpb = p->rpb;
    a.w_fnet = p->w_fnet; a.w_pool = p->w_pool; a.pool_scale = p->pool_scale; a.p_a = p->p_a; a.p_b = p->p_b; a.p_c = p->p_c; a.w_o = p->w_o;
    a.out = p->out; a.ws = p->ws; a.ph_lo = p->ph_lo; a.ph_hi = p->ph_hi;
    return a;
}

DI void ada_task(const Args& A, int task, int lane, bool direct) {
    float* adap = (float*)(A.ws + WS_ADAP);
    {
        const int ng = task % 48, kc = (task / 48) & 15, l = task / 768;
        const int k = kc * 64 + lane;
        float sv[5];
        { const float v = A.c_ctx[k]; sv[0] = v * sigmoidf_(v); }
#pragma unroll
        for (int j = 1; j < 5; ++j) { const float v = A.c[(j - 1) * 1024 + k]; sv[j] = v * sigmoidf_(v); }
        float acc[5] = {0.f, 0.f, 0.f, 0.f, 0.f};
        const float* wp = A.w_ada + ((size_t)l * 1024 + kc * 64) * 3072 + ng * 64 + lane;
#pragma unroll 16
        for (int kk = 0; kk < 64; ++kk) {
            const float w = __builtin_nontemporal_load(wp + (size_t)kk * 3072);
#pragma unroll
            for (int j = 0; j < 5; ++j) acc[j] += __shfl(sv[j], kk) * w;
        }
#pragma unroll
        for (int j = 0; j < 5; ++j) {
            if (direct) atomicAdd((float*)(A.ws + WS_ADA) + (size_t)(l * 5 + j) * 3072 + ng * 64 + lane, acc[j] + (kc == 0 ? A.b_ada[l * 3072 + ng * 64 + lane] : 0.f));
            else adap[((size_t)(kc * 2 + l) * 5 + j) * 3072 + ng * 64 + lane] = acc[j];
        }
    }
}

DI int prow(int L) { return (L & ~31) | (16 * ((L >> 2) & 1) + 4 * ((L >> 3) & 3) + (L & 3)); }
DI int pcol(int p) { return (p & ~31) | (8 * ((p >> 2) & 3) + 4 * ((p >> 4) & 1) + (p & 3)); }
DI int win_row(int n) {
    if (n < 1536) { const int pn = n >> 8, l = n & 255, wc = l >> 6, bj = (l >> 5) & 1, o = l & 31; return pn * 256 + 128 * bj + 32 * wc + o; }
    if (n < 2048) return n;
    if (n < 2304) return -1;
    if (n < 2560) return 2048 + (n - 2304);
    if (n < 2816) return -1;
    if (n < 3072) return 2560 + (n - 2816);
    return 2816 + (n - 3072);
}
template <bool WIN>
DI void transpose_task(const float* src, int K, int N, bf16_t* dst, int dp, int coloff, int wt, int lane) {
    const int nch = N >> 6; const int n = (wt % nch) * 64 + lane, kb = wt / nch;
    const int row0 = WIN ? win_row(n) : n;
    if (row0 < 0) return;
    const int row = prow(row0);
    const float* sp = src + (size_t)(kb * 64) * N + n;
    bf16_t* dq = dst + (size_t)row * dp + coloff + kb * 64;
#pragma unroll 4
    for (int k8 = 0; k8 < 8; ++k8) {
        float v[8];
#pragma unroll
        for (int i = 0; i < 8; ++i) v[i] = __builtin_nontemporal_load(sp + (size_t)(k8 * 8 + i) * N);
        *(u32x4*)(dq + k8 * 8) = pk8(v);
    }
}

DI void fold_pool_task(const Args& A, int task, int lane, LAS float* wl) {
    {
        const int k8 = task & 127, g = (task >> 7) & 3, l = task >> 9;
        const float* wi = A.w_in + (size_t)l * 1024 * INW + (size_t)(k8 * 8) * INW + 2560 + g * 64;
        const float* wp = A.w_pool + ((size_t)(l * 4 + g) * 64) * 64 + lane;
        float acc[8] = {0.f, 0.f, 0.f, 0.f, 0.f, 0.f, 0.f, 0.f};
        {
            float rw[8];
#pragma unroll
            for (int i = 0; i < 8; ++i) rw[i] = wi[(size_t)i * INW + lane];
#pragma unroll
            for (int i = 0; i < 8; ++i) wl[i * 64 + lane] = rw[i];
            asm volatile("" ::: "memory");
        }
#pragma unroll 16
        for (int cc = 0; cc < 64; ++cc) {
            const float p = wp[cc * 64];
#pragma unroll
            for (int i = 0; i < 8; ++i) acc[i] += wl[i * 64 + cc] * p;
        }
        asm volatile("" ::: "memory");
        const float sc = A.pool_scale[l * 256 + g * 64 + lane];
#pragma unroll
        for (int i = 0; i < 8; ++i) acc[i] *= sc;
        bf16_t* dst = (bf16_t*)(A.ws + WS_WIN + (size_t)l * WIN_L) + (size_t)(2304 + prow(g * 64 + lane)) * 1024 + k8 * 8;
        *(u32x4*)dst = pk8(acc);
    }
}

DI void mcs_task(const Args& A, int task, int lane, const LAS f32x2* tbl) {
    float* M = (float*)(A.ws + WS_MCS);
    {
        const int eg = task & 3, m = (task >> 2) & 255, l = task >> 10;
        const int g = m >> 6, n2 = m & 63, e = eg * 64 + lane;
        const float* wf = A.w_fnet + ((size_t)l * 256 + g * 64) * 256 + e;
        float ac = 0.f, as = 0.f;
#pragma unroll 8
        for (int k2 = 0; k2 < 64; ++k2) {
            const f32x2 cs_ = tbl[((n2 * k2) & 63) * 32];
            const float w = wf[(size_t)k2 * 256];
            ac += cs_.x * w; as += cs_.y * w;
        }
        M[((size_t)(l * 2 + 0) * 256 + m) * 256 + e] = ac;
        M[((size_t)(l * 2 + 1) * 256 + m) * 256 + e] = as;
    }
}

DI void dft_task(const Args& A, int task, const LAS f32x2* tbl) {
    bf16_t* DS = (bf16_t*)(A.ws + WS_DS); bf16_t* DP = (bf16_t*)(A.ws + WS_DP);
    const float ss = 1.0f / sqrtf(2048.0f * 64.0f), sp = 1.0f / 128.0f;
    {
        float cv[8], sv[8];
        if (task < 1024 * 256) {
            const int k1 = task >> 8, n0 = (task & 255) * 8;
#pragma unroll
            for (int i = 0; i < 8; ++i) { const f32x2 cs_ = tbl[(k1 * (n0 + i)) & 2047]; cv[i] = cs_.x * ss; sv[i] = -cs_.y * ss; }
            *(u32x4*)(DS + ((size_t)((n0 >> 9) * 1024 + k1)) * 512 + (n0 & 511)) = pk8(cv); *(u32x4*)(DS + ((size_t)((4 + (n0 >> 9)) * 1024 + k1)) * 512 + (n0 & 511)) = pk8(sv);
        } else {
            const int t2 = task - 1024 * 256; const int k1 = t2 >> 5, n0 = (t2 & 31) * 8;
#pragma unroll
            for (int i = 0; i < 8; ++i) { const f32x2 cs_ = tbl[((k1 * (n0 + i)) & 255) * 8]; cv[i] = cs_.x * sp; sv[i] = -cs_.y * sp; }
            *(u32x4*)(DP + (size_t)k1 * 512 + n0) = pk8(cv); *(u32x4*)(DP + (size_t)k1 * 512 + 256 + n0) = pk8(sv);
        }
    }
}

DI void cache_task(const Args& A, int task) {
    bf16_t* CK = (bf16_t*)(A.ws + WS_CK); bf16_t* CV = (bf16_t*)(A.ws + WS_CV);
    {
        const int which = task >> 17, i8 = (task & 131071) * 8;
        const float* s = (which ? A.cache_v : A.cache_k) + i8;
        const f32x4 a = __builtin_nontemporal_load((const f32x4*)s), b = __builtin_nontemporal_load((const f32x4*)(s + 4));
        u32x4 w; w.x = pk2(a[0], a[1]); w.y = pk2(a[2], a[3]); w.z = pk2(b[0], b[1]); w.w = pk2(b[2], b[3]);
        *(u32x4*)((which ? CV : CK) + i8) = w;
    }
}

DI void phase_a(const Args& A, bool direct, LAS unsigned char* lds) {
    const int tid = otid(), lane = tid & 63;
    LAS f32x2* tbl = (LAS f32x2*)lds;
    for (int i = tid; i < 2048; i += blockDim.x) { const float a = (float)i * (1.0f / 1024.0f); tbl[i] = (f32x2){cospif(a), sinpif(a)}; }
    __syncthreads();
    LAS float* wl = (LAS float*)(lds + 16384 + (tid >> 6) * 2048);
    const int gw = __builtin_amdgcn_readfirstlane((blockIdx.x * blockDim.x + tid) >> 6), GW = (gridDim.x * blockDim.x) >> 6;
    constexpr int N_ADA = 1536, N_FP = 1024, N_MCS = 2048, N_WIN = 2 * 1536, N_WO = 2 * 256, N_PA = 2 * 128, N_PB = 2 * 64, N_PC = 2 * 64, N_CACHE = 4096, N_DFT = 4224;
    constexpr int E0 = N_ADA, E1 = E0 + N_FP, E2 = E1 + N_MCS, E3 = E2 + N_WIN, E4 = E3 + N_WO, E5 = E4 + N_PA, E6 = E5 + N_PB, E7 = E6 + N_PC, E8 = E7 + N_CACHE, E9 = E8 + N_DFT;
    for (int id = gw; id < E9; id += GW) {
        if (id < E0) ada_task(A, id, lane, direct);
        else if (id < E1) fold_pool_task(A, id - E0, lane, wl);
        else if (id < E2) mcs_task(A, id - E1, lane, tbl);
        else if (id < E3) { const int w = id - E2, l = w / 1536; transpose_task<true>(A.w_in + (size_t)l * 1024 * INW, 1024, INW, (bf16_t*)(A.ws + WS_WIN + (size_t)l * WIN_L), 1024, 0, w % 1536, lane); }
        else if (id < E4) { const int w = id - E3, l = w / 256; transpose_task<false>(A.w_o + (size_t)l * 1024 * 1024, 1024, 1024, (bf16_t*)(A.ws + WS_WO) + (size_t)l * 1024 * 1024, 1024, 0, w % 256, lane); }
        else if (id < E5) { const int w = id - E4, l = w / 128; transpose_task<false>(A.p_a + (size_t)l * 512 * 1024, 512, 1024, (bf16_t*)(A.ws + WS_PT) + (size_t)l * 1024 * 1024, 1024, 0, w % 128, lane); }
        else if (id < E6) { const int w = id - E5, l = w / 64; transpose_task<false>(A.p_b + (size_t)l * 256 * 1024, 256, 1024, (bf16_t*)(A.ws + WS_PT) + (size_t)l * 1024 * 1024, 1024, 512, w % 64, lane); }
        else if (id < E7) { const int w = id - E6, l = w / 64; transpose_task<false>(A.p_c + (size_t)l * 256 * 1024, 256, 1024, (bf16_t*)(A.ws + WS_PT) + (size_t)l * 1024 * 1024, 1024, 768, w % 64, lane); }
        else if (id < E8) cache_task(A, (id - E7) * 64 + lane);
        else dft_task(A, (id - E8) * 64 + lane, tbl);
    }
}

DI void phase_b(const Args& A, LAS unsigned char* lds, bool direct) {
    const int tid = otid(), lane = tid & 63;
    const int gt = blockIdx.x * blockDim.x + tid, GT = gridDim.x * blockDim.x;
    const int gw = __builtin_amdgcn_readfirstlane(gt >> 6), GW = GT >> 6;
    const float* adap = (const float*)(A.ws + WS_ADAP); float* ada = (float*)(A.ws + WS_ADA);
    if (!direct) for (int i = gt; i < 2 * 5 * 3072; i += GT) {
        const int n = i % 3072, l = i / (5 * 3072);
        float s = A.b_ada[l * 3072 + n];
#pragma unroll
        for (int kc = 0; kc < 16; ++kc) s += adap[(size_t)kc * (2 * 5 * 3072) + i];
        ada[i] = s;
    }
    const float* M = (const float*)(A.ws + WS_MCS);
    LAS float* wl = (LAS float*)(lds + (tid >> 6) * 8192);
    for (int task = gw; task < 2048; task += GW) {
        const int k8 = task & 127, eg = (task >> 7) & 3, s = (task >> 9) & 1, l = task >> 10;
        const float* wi = A.w_in + (size_t)l * 1024 * INW + (size_t)(k8 * 8) * INW + 2048;
        const float* mp = M + ((size_t)(l * 2 + s) * 256) * 256 + eg * 64 + lane;
        f32x4 rw[8];
#pragma unroll
        for (int i = 0; i < 8; ++i) rw[i] = *(const f32x4*)(wi + (size_t)i * INW + lane * 4);
#pragma unroll
        for (int i = 0; i < 8; ++i) *(LAS f32x4*)(wl + i * 256 + lane * 4) = rw[i];
        asm volatile("" ::: "memory");
        float acc[8] = {0.f, 0.f, 0.f, 0.f, 0.f, 0.f, 0.f, 0.f};
#pragma unroll 16
        for (int m = 0; m < 256; ++m) {
            const float mv = mp[(size_t)m * 256];
#pragma unroll
            for (int i = 0; i < 8; ++i) acc[i] += wl[i * 256 + m] * mv;
        }
        asm volatile("" ::: "memory");
        bf16_t* dst = (bf16_t*)(A.ws + WS_WIN + (size_t)l * WIN_L) + (size_t)(5888 + s * 256 + prow(eg * 64 + lane)) * 1024 + k8 * 8;
        *(u32x4*)dst = pk8(acc);
    }
}

DI const float* x_row(const Args& A, int l, int t) {
    if (l == 0) return t < TP ? A.x_prompt + (size_t)t * 1024 : A.x_sample + (size_t)(t - TP) * 1024;
    return A.out + (size_t)t * 1024;
}
DI int cond_of(int t) { return t < TP ? 0 : 1 + ((t - TP) >> 11); }

DI void sw_tasks(const Args& A, int gw, int GW, int lane) {
    const float* ada = (const float*)(A.ws + WS_ADA);
    {
        float sh[5][16];
#pragma unroll
        for (int j = 0; j < 5; ++j)
#pragma unroll
            for (int q = 0; q < 4; ++q) { const f32x4 v = *(const f32x4*)(ada + (size_t)(5 + j) * 3072 + lane * 16 + q * 4); sh[j][4 * q] = v[0]; sh[j][4 * q + 1] = v[1]; sh[j][4 * q + 2] = v[2]; sh[j][4 * q + 3] = v[3]; }
        const bf16_t* W1 = (const bf16_t*)(A.ws + WS_WIN + WIN_L); float* SW = (float*)(A.ws + WS_SW);
        for (int n = gw; n < 6400; n += GW) {
            const u32x4 w0 = *(const u32x4*)(W1 + (size_t)n * 1024 + lane * 16), w1 = *(const u32x4*)(W1 + (size_t)n * 1024 + lane * 16 + 8);
            const float wv[16] = {bflo(w0.x), bfhi(w0.x), bflo(w0.y), bfhi(w0.y), bflo(w0.z), bfhi(w0.z), bflo(w0.w), bfhi(w0.w), bflo(w1.x), bfhi(w1.x), bflo(w1.y), bfhi(w1.y), bflo(w1.z), bfhi(w1.z), bflo(w1.w), bfhi(w1.w)};
#pragma unroll
            for (int j = 0; j < 5; ++j) {
                float a = 0.f;
#pragma unroll
                for (int q = 0; q < 16; ++q) a += sh[j][q] * wv[q];
#pragma unroll
                for (int o = 32; o >= 1; o >>= 1) a += __shfl_xor(a, o);
                if (lane == 0) SW[j * 6400 + n] = a;
            }
        }
    }
}

DI void phase_norm(const Args& A, int l, bool do_sw) {
    const int tid = otid(), lane = tid & 63;
    const int gw = __builtin_amdgcn_readfirstlane((blockIdx.x * blockDim.x + tid) >> 6), GW = (gridDim.x * blockDim.x) >> 6;
    const float* ada = (const float*)(A.ws + WS_ADA);
    if (l == 0 && do_sw) sw_tasks(A, gw, GW, lane);
    bf16_t* XH = (bf16_t*)(A.ws + WS_XH);
    for (int t0 = gw; t0 < T; t0 += 6 * GW) {
        f32x4 v[6][4]; float ss[6];
#pragma unroll
        for (int q = 0; q < 6; ++q) {
            const int t = min(t0 + q * GW, T - 1);
            const float* xr = x_row(A, l, t);
#pragma unroll
            for (int i = 0; i < 4; ++i) v[q][i] = *(const f32x4*)(xr + i * 256 + lane * 4);
        }
#pragma unroll
        for (int q = 0; q < 6; ++q) {
            float a = 0.f;
#pragma unroll
            for (int i = 0; i < 4; ++i) a += v[q][i][0] * v[q][i][0] + v[q][i][1] * v[q][i][1] + v[q][i][2] * v[q][i][2] + v[q][i][3] * v[q][i][3];
#pragma unroll
            for (int o = 32; o >= 1; o >>= 1) a += __shfl_xor(a, o);
            ss[q] = rsqrtf(a * (1.0f / 1024.0f) + EPS);
        }
#pragma unroll
        for (int q = 0; q < 6; ++q) {
            const int t = t0 + q * GW;
            if (t < T) {
                const int j = cond_of(t);
                const float* sh = ada + (size_t)(l * 5 + j) * 3072; const float* sc = sh + 1024;
#pragma unroll
                for (int i = 0; i < 4; ++i) {
                    const int c0 = i * 256 + lane * 4;
                    const f32x4 g = *(const f32x4*)(A.norm_g + l * 1024 + c0), s1 = *(const f32x4*)(sc + c0), s0 = *(const f32x4*)(sh + c0);
                    float o[4];
#pragma unroll
                    for (int e = 0; e < 4; ++e) o[e] = v[q][i][e] * ss[q] * g[e] * (1.0f + s1[e]) + s0[e];
                    u32x2 w; w.x = pk2(o[0], o[1]); w.y = pk2(o[2], o[3]);
                    *(u32x2*)(XH + (size_t)t * 1024 + c0) = w;
                }
            }
        }
    }
}

constexpr size_t TILE1K = 256ull * 1024 * 2;
struct InSched {
    const char* XH; const char* W; int c, G;
    DI bool next(int i, Unit& u) const {
        int pm, pnn;
        if (G == 256) { const int xcd = c & 7, slot = c >> 3, j = i * 32 + slot; if (j >= 150) return false; pnn = j / 6; pm = xcd * 6 + j % 6; }
        else { const int L = i * G + c; if (L >= 1200) return false; pm = L % 48; pnn = L / 48; }
        if (pnn < 23) { u.a = XH + (size_t)pm * TILE1K; u.b = W + (size_t)pnn * TILE1K; u.k0 = 0; u.k1 = pm; u.k2 = pnn; u.k3 = 0; }
        else { u.a = W + (size_t)pnn * TILE1K; u.b = XH + (size_t)pm * TILE1K; u.k0 = 1; u.k1 = pnn - 23; u.k2 = pm; u.k3 = 0; }
        return true;
    }
};
struct EpiIn {
    int l; int fused; unsigned char* ws; float* outk; const float* qg; const float* kg;
    DI void operator()(f32x4 (&acc)[2][2][4][2], const Unit& u, int wr, int wc, int fr, int fq) const {
        LAUNDER();
        bf16_t* const QB = (bf16_t*)(ws + WS_QB); bf16_t* const Gb = (bf16_t*)(ws + WS_G); bf16_t* const UC = (bf16_t*)(ws + WS_UC); bf16_t* const SG = (bf16_t*)(ws + WS_SG);
        bf16_t* const VTS = (bf16_t*)(ws + WS_VTS); bf16_t* const VTP = (bf16_t*)(ws + WS_VTP); const float* const rss = (const float*)(ws + WS_RSS); const float* const sw = (const float*)(ws + WS_SW);
        if (u.k0 == 0) {
            const int pm = u.k1, pn = u.k2;
            if (fused) {
                const float* swp = sw + (size_t)cond_of(256 * pm) * 6400 + 256 * pn + 32 * wc + 4 * fq;
                f32x4 sw4[2][2];
#pragma unroll
                for (int bj = 0; bj < 2; ++bj)
#pragma unroll
                    for (int n = 0; n < 2; ++n) sw4[bj][n] = *(const f32x4*)(swp + 128 * bj + 16 * n);
#pragma unroll
                for (int ai = 0; ai < 2; ++ai)
#pragma unroll
                    for (int m = 0; m < 4; ++m) {
                        const float rs = rsqrtf(rss[256 * pm + 128 * ai + 64 * wr + 16 * m + fr] * (1.0f / 1024.0f) + EPS);
#pragma unroll
                        for (int bj = 0; bj < 2; ++bj)
#pragma unroll
                            for (int n = 0; n < 2; ++n) acc[ai][bj][m][n] = acc[ai][bj][m][n] * rs + sw4[bj][n];
                    }
            }
#define VAL(ai, bj, m, n) (acc[ai][bj][m][n])
            if (pn < 6) {
                const int kind = pn >> 1, head = (pn & 1) * 4 + wc;
                bf16_t* buf = QB + (size_t)kind * ((size_t)T * 512);
                float* ob = outk + (size_t)(kind - 1) * (16ull * 2 * 8 * 256 * 64);
                const float* gp = kind == 0 ? qg : kg;
                const float qs = kind == 0 ? 0.125f * LOG2E : 1.0f;
                f32x4 gv[2][2];
#pragma unroll
                for (int bj = 0; bj < 2; ++bj)
#pragma unroll
                    for (int n = 0; n < 2; ++n) gv[bj][n] = kind < 2 ? *(const f32x4*)(gp + l * 64 + 32 * bj + 8 * fq + 4 * n) * qs : (f32x4){1.f, 1.f, 1.f, 1.f};
#pragma unroll
                for (int ai = 0; ai < 2; ++ai)
#pragma unroll
                    for (int m = 0; m < 4; ++m) {
                        const int r = 128 * ai + 64 * wr + 16 * m + fr; const int t = 256 * pm + r;
                        float rstd = 1.0f;
                        if (kind < 2) {
                            float ss = 0.f;
#pragma unroll
                            for (int bj = 0; bj < 2; ++bj)
#pragma unroll
                                for (int n = 0; n < 2; ++n) { const f32x4 v = VAL(ai, bj, m, n); ss += v[0] * v[0] + v[1] * v[1] + v[2] * v[2] + v[3] * v[3]; }
                            ss += __shfl_xor(ss, 16); ss += __shfl_xor(ss, 32);
                            rstd = rsqrtf(ss * (1.0f / 64.0f) + EPS);
                        }
#pragma unroll
                        for (int bj = 0; bj < 2; ++bj) {
                            const int d0 = 32 * bj + 8 * fq;
                            const f32x4 v0 = VAL(ai, bj, m, 0) * rstd * gv[bj][0], v1 = VAL(ai, bj, m, 1) * rstd * gv[bj][1];
                            u32x4 w; w.x = pk2(v0[0], v0[1]); w.y = pk2(v0[2], v0[3]); w.z = pk2(v1[0], v1[1]); w.w = pk2(v1[2], v1[3]);
                            *(u32x4*)(buf + (size_t)t * 512 + head * 64 + d0) = w;
                            if (kind >= 1 && pm < 16) { float* op = ob + ((size_t)((pm * 2 + l) * 8 + head) * 256 + r) * 64 + d0; *(f32x4*)op = v0; *(f32x4*)(op + 4) = v1; }
                        }
                    }
            } else {
                bf16_t* base; int ld, mode;
                if (pn < 9) { base = Gb + (pn - 6) * 256; ld = 1024; mode = 1; }
                else if (pn == 9) { base = UC; ld = 256; mode = 0; }
                else if (pn == 10) { base = Gb + 768; ld = 1024; mode = 1; }
                else {
                    bf16_t* tb = SG + ((size_t)(((pn - 11) >> 2) * 48 + pm) * 4 + ((pn - 11) & 3)) * 65536 + (size_t)((wr * 4 + wc) * 16 * 64 + fq * 16 + fr) * 8;
#pragma unroll
                    for (int ai = 0; ai < 2; ++ai)
#pragma unroll
                        for (int m = 0; m < 4; ++m)
#pragma unroll
                            for (int bj = 0; bj < 2; ++bj) {
                                float o[8];
#pragma unroll
                                for (int n = 0; n < 2; ++n) {
                                    const f32x4 v = VAL(ai, bj, m, n);
#pragma unroll
                                    for (int e = 0; e < 4; ++e) o[4 * n + e] = sigmoidf_(v[e]);
                                }
                                *(u32x4*)(tb + (size_t)(((ai * 4 + m) * 2 + bj) * 64) * 8) = pk8(o);
                            }
                    return;
                }
#pragma unroll
                for (int ai = 0; ai < 2; ++ai)
#pragma unroll
                    for (int m = 0; m < 4; ++m) {
                        const int r = 128 * ai + 64 * wr + 16 * m + fr;
                        bf16_t* rowp = base + (size_t)(256 * pm + r) * ld + 32 * wc + 8 * fq;
#pragma unroll
                        for (int bj = 0; bj < 2; ++bj) {
                            float o[8];
#pragma unroll
                            for (int n = 0; n < 2; ++n) {
                                const f32x4 v = VAL(ai, bj, m, n);
#pragma unroll
                                for (int e = 0; e < 4; ++e) { const float s = sigmoidf_(v[e]); o[4 * n + e] = mode == 0 ? v[e] : v[e] * s; }
                            }
                            *(u32x4*)(rowp + 128 * bj) = pk8(o);
                        }
                    }
            }
#undef VAL
        } else {
            const int s = u.k1, pt = u.k2;
            bf16_t* base;
            if (pt < 16) base = VTP + (size_t)pt * 256 * 512 + s * 256;
            else { const int ts0 = 256 * (pt - 16), b = ts0 >> 11, n10 = ts0 & 2047; base = VTS + ((size_t)(b * 8 + s * 4 + (n10 >> 9)) * 256) * 512 + (n10 & 511); }
            f32x4 rs4[2][2];
#pragma unroll
            for (int bj = 0; bj < 2; ++bj)
#pragma unroll
                for (int n = 0; n < 2; ++n) {
                    rs4[bj][n] = (f32x4){1.f, 1.f, 1.f, 1.f};
                    if (fused) { const f32x4 q = *(const f32x4*)(rss + 256 * pt + 128 * bj + 32 * wc + 16 * n + 4 * fq);
                        rs4[bj][n] = (f32x4){rsqrtf(q[0] * (1.0f / 1024.0f) + EPS), rsqrtf(q[1] * (1.0f / 1024.0f) + EPS), rsqrtf(q[2] * (1.0f / 1024.0f) + EPS), rsqrtf(q[3] * (1.0f / 1024.0f) + EPS)}; }
                }
            const float* swp = sw + (size_t)cond_of(256 * pt) * 6400 + 5888 + 256 * s;
#pragma unroll
            for (int ai = 0; ai < 2; ++ai)
#pragma unroll
                for (int m = 0; m < 4; ++m) {
                    const int r = 128 * ai + 64 * wr + 16 * m + fr;
                    const float swr = fused ? swp[r] : 0.f;
                    bf16_t* rowp = base + (size_t)r * 512 + 32 * wc + 4 * fq;
#pragma unroll
                    for (int bj = 0; bj < 2; ++bj)
#pragma unroll
                        for (int n = 0; n < 2; ++n) {
                            const f32x4 v = fused ? acc[ai][bj][m][n] * rs4[bj][n] + swr : acc[ai][bj][m][n];
                            u32x2 w; w.x = pk2(v[0], v[1]); w.y = pk2(v[2], v[3]);
                            *(u32x2*)(rowp + 128 * bj + 16 * n) = w;
                        }
                }
        }
    }
};

struct FourSched {
    const char* DS; const char* DP; const char* VTS; const char* VTP; int c, G;
    DI bool next(int i, Unit& u) const {
        const int f = i * G + c; if (f >= 144) return false;
        if (f < 128) { const int b = f >> 5, pm = (f >> 3) & 3, kc = f & 7;
            u.a = DS + ((size_t)(kc * 1024 + pm * 256) * 512) * 2; u.b = VTS + ((size_t)(b * 8 + kc) * 256 * 512) * 2; u.k0 = 0; u.k1 = b; u.k2 = pm; u.k3 = kc; }
        else { const int b = f - 128; u.a = DP; u.b = VTP + (size_t)b * 256 * 512 * 2; u.k0 = 1; u.k1 = b; u.k2 = 0; u.k3 = 0; }
        return true;
    }
};
struct EpiFour {
    bf16_t* YS; bf16_t* YP;
    DI void operator()(const f32x4 (&acc)[2][2][4][2], const Unit& u, int wr, int wc, int fr, int fq) const {
        LAUNDER();
        bf16_t* base = u.k0 == 0 ? YS + ((size_t)u.k3 * 8192 + u.k1 * 2048 + u.k2 * 256) * 256 : YP + (size_t)u.k1 * 256 * 256;
#pragma unroll
        for (int ai = 0; ai < 2; ++ai)
#pragma unroll
            for (int m = 0; m < 4; ++m) {
                const int r = 128 * ai + 64 * wr + 16 * m + fr;
                bf16_t* rowp = base + (size_t)r * 256 + 32 * wc + 8 * fq;
#pragma unroll
                for (int bj = 0; bj < 2; ++bj) {
                    const f32x4 v0 = acc[ai][bj][m][0], v1 = acc[ai][bj][m][1];
                    u32x4 w; w.x = pk2(v0[0], v0[1]); w.y = pk2(v0[2], v0[3]); w.z = pk2(v1[0], v1[1]); w.w = pk2(v1[2], v1[3]);
                    *(u32x4*)(rowp + 128 * bj) = w;
                }
            }
    }
};

DI int crow(int i, int hf) { return (i & 3) + 8 * (i >> 2) + 4 * hf; }
DI s16x4 tr_read(const LAS unsigned char* p) { return __builtin_bit_cast(s16x4, __builtin_amdgcn_ds_read_tr16_b64_v4i16((LAS s16x4*)p)); }

constexpr int VROW = 144, PBUF = 64 * VROW, STG = 2 * PBUF;
constexpr int RPB_LDS = 15360;

DI void attn_wg(const Args& A, int l, int kind, int b, int h, int r4, LAS unsigned char* lds, int wid, int lane, int tid, int dry) {
    const bf16_t* QB = (const bf16_t*)(A.ws + WS_QB); const bf16_t* KB = (const bf16_t*)(A.ws + WS_KB); const bf16_t* VB = (const bf16_t*)(A.ws + WS_VB);
    const bf16_t* CK = (const bf16_t*)(A.ws + WS_CK); const bf16_t* CV = (const bf16_t*)(A.ws + WS_CV);
    bf16_t* Gb = (bf16_t*)(A.ws + WS_G);
    const LAS float* rpbL = (const LAS float*)lds + 64 + h * 465;
    LAS unsigned char* sb = lds + RPB_LDS;
    const int r = lane & 31, hf = lane >> 5;
    int qtok, npair, rs = 0, rsU = 0, grow = 0, hq = 0;
    if (kind == 0) {
        grow = r4 * 4 + (wid >> 1); hq = wid & 1; qtok = TP + b * 2048 + grow * 64 + hq * 32 + r;
        rs = min(max(grow - 4, 0), 24); rsU = min(max(r4 * 4 - 4, 0), 24);
        const int rsL = min(max(r4 * 4 + 3 - 4, 0), 24);
        npair = 4 + (rsL + 8 - rsU);
    } else { qtok = b * 256 + wid * 32 + r; npair = 4; }
    const int qc = hq * 32 + r, cs = min(max(qc - 8, 0), 48);
    bf16x8 qf[4];
#pragma unroll
    for (int s = 0; s < 4; ++s) qf[s] = *(const bf16x8*)(QB + (size_t)qtok * 512 + h * 64 + 16 * s + 8 * hf);
    f32x16 o0, o1;
#pragma unroll
    for (int i = 0; i < 16; ++i) { o0[i] = 0.f; o1[i] = 0.f; }
    float mrun = -1e30f, lrun = 0.f;
    auto pair_ptrs = [&](int pi, const bf16_t*& kp, const bf16_t*& vp, int& pitch) {
        if (kind == 0) {
            if (pi < 4) { const size_t off = ((size_t)((b * 2 + l) * 8 + h) * 256 + 64 * pi) * 64; kp = CK + off; vp = CV + off; pitch = 64; }
            else { const size_t off = (size_t)(TP + b * 2048 + (rsU + pi - 4) * 64) * 512 + h * 64; kp = KB + off; vp = VB + off; pitch = 512; }
        } else { const size_t off = (size_t)(b * 256 + 64 * pi) * 512 + h * 64; kp = KB + off; vp = VB + off; pitch = 512; }
    };
    const int lrow = tid >> 3, lc16 = tid & 7;
    const int ldst = lrow * VROW + lc16 * 16;
    u32x4 kR[3], vR[3];
#define ATT_LOAD(J, P) do { if ((P) < npair) { const bf16_t* kp_; const bf16_t* vp_; int pitch_; pair_ptrs((P), kp_, vp_, pitch_); \
        kR[J] = *(const u32x4*)(kp_ + (size_t)lrow * pitch_ + lc16 * 8); vR[J] = *(const u32x4*)(vp_ + (size_t)lrow * pitch_ + lc16 * 8); } } while (0)
    ATT_LOAD(0, 0); ATT_LOAD(1, 1); ATT_LOAD(2, 2);
    __syncthreads();
    *(LAS u32x4*)(sb + ldst) = kR[0]; *(LAS u32x4*)(sb + PBUF + ldst) = vR[0];
    __syncthreads();
    for (int pi0 = 0; pi0 < npair; pi0 += 3) {
#pragma unroll
      for (int jj = 0; jj < 3; ++jj) {
        const int pi = pi0 + jj;
        if (pi < npair) {
        const bool more = pi + 1 < npair;
        if (jj == 0) ATT_LOAD(0, pi + 3); else if (jj == 1) ATT_LOAD(1, pi + 3); else ATT_LOAD(2, pi + 3);
        const int wrow = rsU + pi - 4;
        const bool mine = (kind != 0) || pi < 4 || (wrow >= rs && wrow < rs + 8);
        if (mine) {
            const LAS unsigned char* kb_ = sb + (pi & 1) * STG;
            const LAS unsigned char* vb_ = kb_ + PBUF;
            bf16x8 kf[2][4];
#pragma unroll
            for (int u = 0; u < 2; ++u)
#pragma unroll
                for (int s = 0; s < 4; ++s) kf[u][s] = *(const LAS bf16x8*)(kb_ + (32 * u + r) * VROW + (16 * s + 8 * hf) * 2);
            f32x16 x0, x1;
#pragma unroll
            for (int i = 0; i < 16; ++i) { x0[i] = 0.f; x1[i] = 0.f; }
#pragma unroll
            for (int s = 0; s < 4; ++s) { x0 = __builtin_amdgcn_mfma_f32_32x32x16_bf16(kf[0][s], qf[s], x0, 0, 0, 0); x1 = __builtin_amdgcn_mfma_f32_32x32x16_bf16(kf[1][s], qf[s], x1, 0, 0, 0); }
            const bool win = (kind == 0 && pi >= 4);
            bool lv[2][4];
#pragma unroll
            for (int g = 0; g < 4; ++g) { lv[0][g] = !win || hq == 0 || g == 3; lv[1][g] = !win || hq == 1 || g == 0; }
            if (win) {
                const int ridx = wrow - grow + 7;
                int csl = cs - 4 * hf, bl = 4 * hf - qc + 15;
                asm volatile("" : "+v"(csl), "+v"(bl));
                const LAS float* rp = rpbL + ridx * 31 + bl;
#pragma unroll
                for (int g = 0; g < 4; ++g) {
                    if (lv[0][g]) {
#pragma unroll
                        for (int jx = 0; jx < 4; ++jx) { const int i = 4 * g + jx, ci = jx + 8 * g; const bool valid = (unsigned)(ci - csl) < 16u; const float bias = rp[ci]; x0[i] = valid ? x0[i] + bias : -1e30f; }
                    }
                    if (lv[1][g]) {
#pragma unroll
                        for (int jx = 0; jx < 4; ++jx) { const int i = 4 * g + jx, ci = jx + 8 * g; const bool valid = (unsigned)(ci + 32 - csl) < 16u; const float bias = rp[ci + 32]; x1[i] = valid ? x1[i] + bias : -1e30f; }
                    }
                }
            }
            float mx = -1e30f;
#pragma unroll
            for (int g = 0; g < 4; ++g) {
                if (lv[0][g]) mx = fmaxf(fmaxf(mx, fmaxf(x0[4 * g], x0[4 * g + 1])), fmaxf(x0[4 * g + 2], x0[4 * g + 3]));
                if (lv[1][g]) mx = fmaxf(fmaxf(mx, fmaxf(x1[4 * g], x1[4 * g + 1])), fmaxf(x1[4 * g + 2], x1[4 * g + 3]));
            }
            mx = fmaxf(mx, __shfl_xor(mx, 32));
            const bool rebase = __builtin_amdgcn_ballot_w64(mx > mrun + 8.0f) != 0ull;
            const float mnew = rebase ? fmaxf(mrun, mx) : mrun;
            float psum = 0.f;
#pragma unroll
            for (int g = 0; g < 4; ++g) {
                if (lv[0][g]) {
#pragma unroll
                    for (int jx = 0; jx < 4; ++jx) { const int i = 4 * g + jx; x0[i] = __builtin_amdgcn_exp2f(x0[i] - mnew); psum += x0[i]; }
                } else {
#pragma unroll
                    for (int jx = 0; jx < 4; ++jx) x0[4 * g + jx] = 0.f;
                }
                if (lv[1][g]) {
#pragma unroll
                    for (int jx = 0; jx < 4; ++jx) { const int i = 4 * g + jx; x1[i] = __builtin_amdgcn_exp2f(x1[i] - mnew); psum += x1[i]; }
                } else {
#pragma unroll
                    for (int jx = 0; jx < 4; ++jx) x1[4 * g + jx] = 0.f;
                }
            }
            if (rebase) {
                const float alpha = __builtin_amdgcn_exp2f(mrun - mnew);
                lrun *= alpha; mrun = mnew;
#pragma unroll
                for (int i = 0; i < 16; ++i) { o0[i] *= alpha; o1[i] *= alpha; }
            }
            lrun += psum;
            const int q4 = (lane & 15) >> 2, p4 = lane & 3, blk = (lane >> 4) & 1;
#pragma unroll
            for (int u = 0; u < 2; ++u) {
                const LAS unsigned char* vcur = vb_ + (32 * u + 4 * hf + q4) * VROW + (16 * blk + 4 * p4) * 2;
#pragma unroll
                for (int s2 = 0; s2 < 2; ++s2) {
                    if (lv[u][2 * s2] || lv[u][2 * s2 + 1]) {
                        s16x4 lo[2], hi[2];
#pragma unroll
                        for (int db = 0; db < 2; ++db) { lo[db] = tr_read(vcur + (16 * s2) * VROW + 64 * db); hi[db] = tr_read(vcur + (16 * s2 + 8) * VROW + 64 * db); }
                        u32x4 pw;
                        if (u == 0) { pw.x = pk2(x0[8 * s2 + 0], x0[8 * s2 + 1]); pw.y = pk2(x0[8 * s2 + 2], x0[8 * s2 + 3]); pw.z = pk2(x0[8 * s2 + 4], x0[8 * s2 + 5]); pw.w = pk2(x0[8 * s2 + 6], x0[8 * s2 + 7]); }
                        else        { pw.x = pk2(x1[8 * s2 + 0], x1[8 * s2 + 1]); pw.y = pk2(x1[8 * s2 + 2], x1[8 * s2 + 3]); pw.z = pk2(x1[8 * s2 + 4], x1[8 * s2 + 5]); pw.w = pk2(x1[8 * s2 + 6], x1[8 * s2 + 7]); }
                        const bf16x8 pb = __builtin_bit_cast(bf16x8, pw);
                        const bf16x8 va0 = __builtin_shufflevector(lo[0], hi[0], 0, 1, 2, 3, 4, 5, 6, 7);
                        const bf16x8 va1 = __builtin_shufflevector(lo[1], hi[1], 0, 1, 2, 3, 4, 5, 6, 7);
                        o0 = __builtin_amdgcn_mfma_f32_32x32x16_bf16(va0, pb, o0, 0, 0, 0);
                        o1 = __builtin_amdgcn_mfma_f32_32x32x16_bf16(va1, pb, o1, 0, 0, 0);
                    }
                }
            }
        }
        if (more) {
            LAS unsigned char* nb = sb + ((pi + 1) & 1) * STG;
            const int jn = (jj + 1) % 3;
            *(LAS u32x4*)(nb + ldst) = kR[jn]; *(LAS u32x4*)(nb + PBUF + ldst) = vR[jn];
        }
        __syncthreads();
        }
      }
    }
#undef ATT_LOAD
    const float ltot = lrun + __shfl_xor(lrun, 32);
    const float inv = 1.0f / ltot;
    bf16_t* zrow = Gb + (size_t)qtok * 1024 + h * 64;
    u32x2 z[2][4];
#pragma unroll
    for (int db = 0; db < 2; ++db)
#pragma unroll
        for (int g = 0; g < 4; ++g) z[db][g] = *(const u32x2*)(zrow + 32 * db + 8 * g + 4 * hf);
#pragma unroll
    for (int db = 0; db < 2; ++db)
#pragma unroll
        for (int g = 0; g < 4; ++g) {
            const int d0 = 32 * db + 8 * g + 4 * hf;
            float ov[4];
#pragma unroll
            for (int j = 0; j < 4; ++j) ov[j] = (db == 0 ? o0[4 * g + j] : o1[4 * g + j]) * inv;
            u32x2 w; w.x = pk2(ov[0] * bflo(z[db][g].x), ov[1] * bfhi(z[db][g].x)); w.y = pk2(ov[2] * bflo(z[db][g].y), ov[3] * bfhi(z[db][g].y));
            if (!dry) *(u32x2*)(zrow + d0) = w;
        }
}

DI void pool_tasks(const Args& A, int gt, int GT, int dry) {
    const bf16_t* UC = (const bf16_t*)(A.ws + WS_UC); bf16_t* ZC = (bf16_t*)(A.ws + WS_G) + 768;
    for (int task = gt; task < T * 32; task += GT) {
        const int g = __builtin_amdgcn_readfirstlane(task / (T * 8)), rem = task - g * (T * 8), t = rem >> 3, c0 = g * 64 + (rem & 7) * 8, half = 1 << g;
        int tb, pos, L;
        if (t < TP) { tb = t & ~255; pos = t & 255; L = 256; } else { const int ts = t - TP; tb = TP + (ts & ~2047); pos = ts & 2047; L = 2048; }
        const int lo = max(pos - half, 0), hi = min(pos + half, L);
        float sum[8] = {0.f, 0.f, 0.f, 0.f, 0.f, 0.f, 0.f, 0.f};
#pragma unroll
        for (int j = 0; j < 16; ++j) {
            if (j >= 2 * half) break;
            const int p = lo + j; const bool ok = p < hi;
            const u32x4 w = *(const u32x4*)(UC + (size_t)(tb + (ok ? p : pos)) * 256 + c0);
            if (ok) { sum[0] += bflo(w.x); sum[1] += bfhi(w.x); sum[2] += bflo(w.y); sum[3] += bfhi(w.y); sum[4] += bflo(w.z); sum[5] += bfhi(w.z); sum[6] += bflo(w.w); sum[7] += bfhi(w.w); }
        }
        const float inv = __builtin_amdgcn_rcpf((float)(hi - lo));
        const u32x4 sf = *(const u32x4*)(UC + (size_t)t * 256 + c0);
        const u32x4 z = *(const u32x4*)(ZC + (size_t)t * 1024 + c0);
        const float s[8] = {bflo(sf.x), bfhi(sf.x), bflo(sf.y), bfhi(sf.y), bflo(sf.z), bfhi(sf.z), bflo(sf.w), bfhi(sf.w)};
        const float zz[8] = {bflo(z.x), bfhi(z.x), bflo(z.y), bfhi(z.y), bflo(z.z), bfhi(z.z), bflo(z.w), bfhi(z.w)};
        float o[8];
#pragma unroll
        for (int i = 0; i < 8; ++i) o[i] = zz[i] * (sum[i] * inv - s[i]);
        if (!dry) *(u32x4*)(ZC + (size_t)t * 1024 + c0) = pk8(o);
    }
}

DI void phase_mix(const Args& A, int l, LAS unsigned char* lds, int dry, int parts, bool sw_here) {
    const int tid = otid(), lane = tid & 63, wid = __builtin_amdgcn_readfirstlane(tid >> 6);
    const int c = blockIdx.x, G = gridDim.x;
    if (parts & 1) {
        FourSched S{(const char*)(A.ws + WS_DS), (const char*)(A.ws + WS_DP), (const char*)(A.ws + WS_VTS), (const char*)(A.ws + WS_VTP), c, G};
        EpiFour E{(bf16_t*)(A.ws + WS_XH), (bf16_t*)(A.ws + WS_XH) + 8ull * 8192 * 256};
        pg8::gemm_phase<EpiFour, FourSched>(lds, 512, 512, 8, S, E);
    }
    if (parts & 2) {
    for (int i = tid; i < 8 * 465; i += blockDim.x) ((LAS float*)lds)[64 + i] = A.rpb[(size_t)l * 8 * 465 + i] * LOG2E;
    __syncthreads();
    if (G == 256) {
        { const int wt = c; const int b = wt >> 6, h = (wt >> 3) & 7, r4 = wt & 7; attn_wg(A, l, 0, b, h, r4, lds, wid, lane, tid, dry); }
        if (c >= 144) {
            { const int m = c - 144; const int b = m >> 3, h = m & 7; attn_wg(A, l, 1, b, h, 0, lds, wid, lane, tid, dry); }
            const int r4c = c & 7; const int idx = r4c == 0 ? ((c - 144) >> 3) : (r4c == 7 ? 14 + ((c - 151) >> 3) : 99);
            if (idx < 16) { const int m = 112 + idx; const int b = m >> 3, h = m & 7; attn_wg(A, l, 1, b, h, 0, lds, wid, lane, tid, dry); }
        }
    } else
    for (int wt = c; wt < 384; wt += G) {
        if (wt < 256) { const int b = wt >> 6, h = (wt >> 3) & 7, r4 = wt & 7; attn_wg(A, l, 0, b, h, r4, lds, wid, lane, tid, dry); }
        else { const int m = wt - 256; const int b = m >> 3, h = m & 7; attn_wg(A, l, 1, b, h, 0, lds, wid, lane, tid, dry); }
    }
    }
    if (parts & 4) {
        {
            const bf16_t* VTS = (const bf16_t*)(A.ws + WS_VTS); float* Y1K = (float*)(A.ws + WS_Y1K);
            const int gw = __builtin_amdgcn_readfirstlane((blockIdx.x * blockDim.x + tid) >> 6), GW = (gridDim.x * blockDim.x) >> 6;
            for (int task = gw; task < 1024; task += GW) {
                const int b = task >> 8, e = task & 255;
                const bf16_t* row = VTS + ((size_t)(b * 8 + (lane >> 4)) * 256 + e) * 512 + (lane & 15) * 32;
                float a = 0.f;
#pragma unroll
                for (int q = 0; q < 4; ++q) { const u32x4 w = *(const u32x4*)(row + q * 8);
                    a += (bflo(w.x) - bfhi(w.x)) + (bflo(w.y) - bfhi(w.y)) + (bflo(w.z) - bfhi(w.z)) + (bflo(w.w) - bfhi(w.w)); }
#pragma unroll
                for (int o = 32; o >= 1; o >>= 1) a += __shfl_xor(a, o);
                if (lane == 0 && !dry) Y1K[(task & ~255) + pcol(e)] = a * (1.0f / sqrtf(2048.0f * 64.0f));
            }
        }
        pool_tasks(A, blockIdx.x * blockDim.x + tid, gridDim.x * blockDim.x, dry);
        if (sw_here && !dry) { const int gw2 = __builtin_amdgcn_readfirstlane((blockIdx.x * blockDim.x + tid) >> 6); sw_tasks(A, gw2, (gridDim.x * blockDim.x) >> 6, lane); }
    }
    __syncthreads();
}

DI void phase_gb(const Args& A, int dry) {
    const int gt = blockIdx.x * blockDim.x + otid(), GT = gridDim.x * blockDim.x;
    const bf16_t* YS = (const bf16_t*)(A.ws + WS_XH); const bf16_t* YP = YS + 8ull * 8192 * 256; bf16_t* ZB = (bf16_t*)(A.ws + WS_G) + 512;
    for (int task = gt; task < T * 32; task += GT) {
        const int tt = task >> 5, c0 = (task & 31) * 8;
        const int t = tt < TS ? TP + tt : tt - TS;
        float s[8] = {0.f, 0.f, 0.f, 0.f, 0.f, 0.f, 0.f, 0.f};
        const u32x4 z = *(const u32x4*)(ZB + (size_t)t * 1024 + c0);
        if (t < TP) {
            const u32x4 w = *(const u32x4*)(YP + (size_t)t * 256 + c0);
            s[0] = bflo(w.x); s[1] = bfhi(w.x); s[2] = bflo(w.y); s[3] = bfhi(w.y); s[4] = bflo(w.z); s[5] = bfhi(w.z); s[6] = bflo(w.w); s[7] = bfhi(w.w);
        } else {
            const int ts = t - TP, k1 = ts & 2047;
            if (k1 == 1024) {
                const float* y = (const float*)(A.ws + WS_Y1K) + (ts >> 11) * 256 + c0;
                const f32x4 y0 = *(const f32x4*)y, y1 = *(const f32x4*)(y + 4);
                s[0] = y0[0]; s[1] = y0[1]; s[2] = y0[2]; s[3] = y0[3]; s[4] = y1[0]; s[5] = y1[1]; s[6] = y1[2]; s[7] = y1[3];
            } else {
                const int src = (ts & ~2047) + (k1 < 1024 ? k1 : 2048 - k1);
                const float sg = k1 < 1024 ? 1.0f : -1.0f;
                u32x4 w[8];
#pragma unroll
                for (int kc = 0; kc < 8; ++kc) w[kc] = (k1 > 1024) ? __builtin_nontemporal_load((const u32x4*)(YS + ((size_t)kc * 8192 + src) * 256 + c0)) : *(const u32x4*)(YS + ((size_t)kc * 8192 + src) * 256 + c0);
#pragma unroll
                for (int kc = 0; kc < 8; ++kc) { const float f = kc < 4 ? 1.0f : sg;
                    s[0] += f * bflo(w[kc].x); s[1] += f * bfhi(w[kc].x); s[2] += f * bflo(w[kc].y); s[3] += f * bfhi(w[kc].y); s[4] += f * bflo(w[kc].z); s[5] += f * bfhi(w[kc].z); s[6] += f * bflo(w[kc].w); s[7] += f * bfhi(w[kc].w); }
            }
        }
        float o[8] = {s[0] * bflo(z.x), s[1] * bfhi(z.x), s[2] * bflo(z.y), s[3] * bfhi(z.y), s[4] * bflo(z.z), s[5] * bfhi(z.z), s[6] * bflo(z.w), s[7] * bfhi(z.w)};
        if (!dry) *(u32x4*)(ZB + (size_t)t * 1024 + c0) = pk8(o);
    }
}

struct TileSched {
    const char* Ab; const char* Bb; size_t tileA, tileB; int c, G;
    DI bool next(int i, Unit& u) const { const int f = i * G + c; if (f >= 192) return false; const int pm = f >> 2, pn = f & 3; u.a = Ab + pm * tileA; u.b = Bb + pn * tileB; u.k0 = 0; u.k1 = pm; u.k2 = pn; u.k3 = 0; return true; }
};
struct HookProj {
    static constexpr bool ENABLED = true;
    const bf16_t* SG;
    DI void operator()(f32x4 (&acc)[2][2][4][2], const Unit& u, int t, int wr, int wc, int fr, int fq) const {
        LAUNDER();
        const size_t GT_ = (size_t)48 * 4 * 65536;
        const bf16_t* sp = SG + (t == 8 ? (size_t)0 : GT_) + ((size_t)u.k1 * 4 + u.k2) * 65536 + (size_t)((wr * 4 + wc) * 16 * 64 + fq * 16 + fr) * 8;
#pragma unroll
        for (int ai = 0; ai < 2; ++ai) {
            u32x4 gn[8], gd[8];
#pragma unroll
            for (int q = 0; q < 8; ++q) { gn[q] = __builtin_nontemporal_load((const u32x4*)(sp + (size_t)((ai * 8 + q) * 64) * 8)); gd[q] = *(const u32x4*)(sp + GT_ + (size_t)((ai * 8 + q) * 64) * 8); }
#pragma unroll
            for (int m = 0; m < 4; ++m)
#pragma unroll
                for (int bj = 0; bj < 2; ++bj) {
                    const u32x4 a = gn[m * 2 + bj], d = gd[m * 2 + bj];
                    f32x4 v0 = acc[ai][bj][m][0], v1 = acc[ai][bj][m][1];
                    v0[0] *= bflo(a.x) * __builtin_amdgcn_rcpf(fmaxf(bflo(d.x), 1e-30f)); v0[1] *= bfhi(a.x) * __builtin_amdgcn_rcpf(fmaxf(bfhi(d.x), 1e-30f));
                    v0[2] *= bflo(a.y) * __builtin_amdgcn_rcpf(fmaxf(bflo(d.y), 1e-30f)); v0[3] *= bfhi(a.y) * __builtin_amdgcn_rcpf(fmaxf(bfhi(d.y), 1e-30f));
                    v1[0] *= bflo(a.z) * __builtin_amdgcn_rcpf(fmaxf(bflo(d.z), 1e-30f)); v1[1] *= bfhi(a.z) * __builtin_amdgcn_rcpf(fmaxf(bfhi(d.z), 1e-30f));
                    v1[2] *= bflo(a.w) * __builtin_amdgcn_rcpf(fmaxf(bflo(d.w), 1e-30f)); v1[3] *= bfhi(a.w) * __builtin_amdgcn_rcpf(fmaxf(bfhi(d.w), 1e-30f));
                    acc[ai][bj][m][0] = v0; acc[ai][bj][m][1] = v1;
                }
        }
    }
};
struct EpiProj {
    const bf16_t* SGc; bf16_t* MG;
    DI void operator()(const f32x4 (&acc)[2][2][4][2], const Unit& u, int wr, int wc, int fr, int fq) const {
        LAUNDER();
        const bf16_t* sp = SGc + ((size_t)u.k1 * 4 + u.k2) * 65536 + (size_t)((wr * 4 + wc) * 16 * 64 + fq * 16 + fr) * 8;
#pragma unroll
        for (int ai = 0; ai < 2; ++ai) {
            u32x4 gc[8];
#pragma unroll
            for (int q = 0; q < 8; ++q) gc[q] = __builtin_nontemporal_load((const u32x4*)(sp + (size_t)((ai * 8 + q) * 64) * 8));
#pragma unroll
            for (int m = 0; m < 4; ++m) {
                const int t = 256 * u.k1 + 128 * ai + 64 * wr + 16 * m + fr;
                bf16_t* rowp = MG + (size_t)t * 1024 + 256 * u.k2 + 32 * wc + 8 * fq;
#pragma unroll
                for (int bj = 0; bj < 2; ++bj) {
                    const u32x4 g = gc[m * 2 + bj];
                    const f32x4 v0 = acc[ai][bj][m][0], v1 = acc[ai][bj][m][1];
                    u32x2 w0; w0.x = pk2(v0[0] * bflo(g.x), v0[1] * bfhi(g.x)); w0.y = pk2(v0[2] * bflo(g.y), v0[3] * bfhi(g.y));
                    u32x2 w1; w1.x = pk2(v1[0] * bflo(g.z), v1[1] * bfhi(g.z)); w1.y = pk2(v1[2] * bflo(g.w), v1[3] * bfhi(g.w));
                    u32x4 w01; w01.x = w0.x; w01.y = w0.y; w01.z = w1.x; w01.w = w1.y; *(u32x4*)(rowp + 128 * bj) = w01;
                }
            }
        }
    }
};
struct EpiOut {
    const float* xp; const float* xs; float* out; const float* ng1; int l; const float* ada; int dry; bf16_t* XG; float* rss;
    DI void operator()(const f32x4 (&acc)[2][2][4][2], const Unit& u, int wr, int wc, int fr, int fq) const {
        LAUNDER();
        const int t0 = 256 * u.k1; const int j = cond_of(t0);
        const int cb = 256 * u.k2 + 32 * wc + 8 * fq;
        const float* gate = ada + (size_t)(l * 5 + j) * 3072 + 2048 + cb;
        f32x4 gv[2][2], gm[2][2];
#pragma unroll
        for (int bj = 0; bj < 2; ++bj)
#pragma unroll
            for (int n = 0; n < 2; ++n) {
                gv[bj][n] = *(const f32x4*)(gate + 128 * bj + 4 * n);
                gm[bj][n] = (f32x4){0.f, 0.f, 0.f, 0.f};
                if (XG) gm[bj][n] = *(const f32x4*)(ng1 + cb + 128 * bj + 4 * n) * (*(const f32x4*)(ada + (size_t)(5 + j) * 3072 + 1024 + cb + 128 * bj + 4 * n) + 1.0f);
            }
#pragma unroll
        for (int ai = 0; ai < 2; ++ai)
#pragma unroll
            for (int mh = 0; mh < 2; ++mh) {
                f32x4 xv[2][2][2];
#pragma unroll
                for (int mm = 0; mm < 2; ++mm) {
                    const int t = t0 + 128 * ai + 64 * wr + 16 * (2 * mh + mm) + fr;
                    const float* xr = (l == 0 ? (t < TP ? xp + (size_t)t * 1024 : xs + (size_t)(t - TP) * 1024) : out + (size_t)t * 1024) + cb;
#pragma unroll
                    for (int bj = 0; bj < 2; ++bj)
#pragma unroll
                        for (int n = 0; n < 2; ++n) xv[mm][bj][n] = *(const f32x4*)(xr + 128 * bj + 4 * n);
                }
#pragma unroll
                for (int mm = 0; mm < 2; ++mm) {
                    const int m = 2 * mh + mm;
                    const int t = t0 + 128 * ai + 64 * wr + 16 * m + fr;
                    float* orow = out + (size_t)t * 1024 + cb;
                    float ssq = 0.f;
#pragma unroll
                    for (int bj = 0; bj < 2; ++bj) {
                        const f32x4 xn0 = xv[mm][bj][0] + gv[bj][0] * acc[ai][bj][m][0], xn1 = xv[mm][bj][1] + gv[bj][1] * acc[ai][bj][m][1];
                        if (!dry) { *(f32x4*)(orow + 128 * bj) = xn0; *(f32x4*)(orow + 128 * bj + 4) = xn1; }
                        if (XG) {
                            const f32x4 y0 = xn0 * gm[bj][0], y1 = xn1 * gm[bj][1];
                            u32x4 w; w.x = pk2(y0[0], y0[1]); w.y = pk2(y0[2], y0[3]); w.z = pk2(y1[0], y1[1]); w.w = pk2(y1[2], y1[3]);
                            if (!dry) *(u32x4*)(XG + (size_t)t * 1024 + cb + 128 * bj) = w;
                            ssq += xn0[0] * xn0[0] + xn0[1] * xn0[1] + xn0[2] * xn0[2] + xn0[3] * xn0[3] + xn1[0] * xn1[0] + xn1[1] * xn1[1] + xn1[2] * xn1[2] + xn1[3] * xn1[3];
                        }
                    }
                    if (XG) {
                        ssq += __shfl_xor(ssq, 16); ssq += __shfl_xor(ssq, 32);
                        if (fq == 0 && !dry) atomicAdd(rss + t, ssq);
                    }
                }
            }
    }
};

__global__ void __launch_bounds__(512, 2) mk_fwd(Args A0) {
    const Args& A = A0;
    extern __shared__ __attribute__((aligned(16))) unsigned char lds_raw[];
    LAS unsigned char* lds = (LAS unsigned char*)lds_raw;
    cg::grid_group grid = cg::this_grid();
    const int lo = A.ph_lo, hi = A.ph_hi;
    if (threadIdx.x < 4) ((LAS unsigned*)(lds + LDS_RING))[threadIdx.x] = 0u;
    __syncthreads();
    XcdBarrier xbar = xcd_barrier_post((unsigned*)(A.ws + WS_BAR), (volatile LAS unsigned*)(lds + LDS_RING));
    if (hi > 1000) grid.sync();
    const int c = blockIdx.x, G = gridDim.x;
    const bool fuse1 = (lo == 0 && hi == 14);
#define IN(k) (lo <= (k) && (k) < hi)
#define SEAM(k) do { if (IN(k) && IN((k) + 1)) xcd_barrier(xbar); } while (0)
#if defined(PROBE_PHASE)
#define NREPS(k) (((k) == PROBE_PHASE) ? 1 + PROBE_REPS : 1)
#else
#define NREPS(k) 1
#endif
#if defined(PROBE_PARTS)
#define PARTS(dry) ((dry) ? PROBE_PARTS : 7)
#else
#define PARTS(dry) 7
#endif
#define PHASE(k, ...) do { if (IN(k)) { const int nreps_ = NREPS(k); for (int rep_ = 0; rep_ < nreps_; ++rep_) { const int dry = rep_ > 0; (void)dry; if (rep_ > 0) xcd_barrier(xbar); \
        KArgP ap_ = (KArgP)__builtin_amdgcn_kernarg_segment_ptr(); asm volatile("" : "+s"(ap_)); \
        const Args& A = *(const Args*)ap_;     \
        __VA_ARGS__ } } SEAM(k); } while (0)
#if defined(PROBE_A_REPS)
    for (int r = 0; r < PROBE_A_REPS; ++r) phase_a(A, fuse1, lds);
#endif
    PHASE(0, phase_a(A, fuse1, lds););
#if defined(PROBE_SYNCS)
    for (int r = 0; r < PROBE_SYNCS; ++r) xcd_barrier(xbar);
#endif
    PHASE(1, { phase_b(A, lds, fuse1); if (fuse1) phase_norm(A, 0, false); });
    for (int l = 0; l < 2; ++l) {
        const int p0 = 2 + 6 * l;
        if (!fuse1) PHASE(p0, phase_norm(A, l, true););
        PHASE(p0 + 1, {
            InSched S{(const char*)(A.ws + WS_XH), (const char*)(A.ws + WS_WIN + (size_t)l * WIN_L), c, G};
            EpiIn E{l, (l == 1 && fuse1) ? 1 : 0, A.ws, A.out + (size_t)T * 1024, A.q_g, A.k_g};
            pg8::gemm_phase<EpiIn, InSched>(lds, 1024, 1024, 16, S, E);
        });
        PHASE(p0 + 2, phase_mix(A, l, lds, dry, PARTS(dry), fuse1 && l == 0););
        PHASE(p0 + 3, phase_gb(A, dry););
        PHASE(p0 + 4, {
            const bf16_t* SG = (const bf16_t*)(A.ws + WS_SG);
            TileSched S{(const char*)(A.ws + WS_G), (const char*)(A.ws + WS_PT + (size_t)l * 1024 * 1024 * 2), TILE1K, TILE1K, c, G};
            EpiProj E{SG + 2 * (size_t)48 * 4 * 65536, (bf16_t*)(A.ws + WS_QB)};
            HookProj H{SG};
            pg8::gemm_phase<EpiProj, TileSched, HookProj>(lds, 1024, 1024, 16, S, E, H);
        });
        PHASE(p0 + 5, {
            TileSched S{(const char*)(A.ws + WS_QB), (const char*)(A.ws + WS_WO + (size_t)l * 1024 * 1024 * 2), TILE1K, TILE1K, c, G};
            EpiOut E{A.x_prompt, A.x_sample, A.out, A.norm_g + 1024, l, (const float*)(A.ws + WS_ADA), dry, (l == 0 && fuse1) ? (bf16_t*)(A.ws + WS_XH) : (bf16_t*)nullptr, (float*)(A.ws + WS_RSS)};
            pg8::gemm_phase<EpiOut, TileSched>(lds, 1024, 1024, 16, S, E);
        });
    }
#undef IN
#undef SEAM
}

extern "C" void kernel_launch(void* const* d_in, const int* in_sizes, int n_in, void* d_out, int out_size, void* d_ws, size_t ws_size, hipStream_t stream) {
    static int grid = 0;
    if (grid == 0) {
        if (ws_size < WS_END) { fprintf(stderr, "kernel_launch: workspace too small: %zu < %zu\n", ws_size, (size_t)WS_END); grid = -1; return; }
        int dev = 0, cus = 0, per_cu = 0;
        hipGetDevice(&dev);
        hipDeviceGetAttribute(&cus, hipDeviceAttributeMultiprocessorCount, dev);
        if (hipFuncSetAttribute((const void*)mk_fwd, hipFuncAttributeMaxDynamicSharedMemorySize, LDS_BYTES) != hipSuccess) { fprintf(stderr, "kernel_launch: hipFuncSetAttribute failed\n"); grid = -1; return; }
        hipOccupancyMaxActiveBlocksPerMultiprocessor(&per_cu, (const void*)mk_fwd, 512, LDS_BYTES);
        (void)hipGetLastError();
        if (per_cu < 1) per_cu = 1;
        grid = cus;
        if (grid <= 0) grid = 256;
    }
    if (grid < 0) return;
    Args a{};
    a.x_prompt = (const float*)d_in[0]; a.x_sample = (const float*)d_in[1]; a.cache_k = (const float*)d_in[2]; a.cache_v = (const float*)d_in[3];
    a.c = (const float*)d_in[4]; a.c_ctx = (const float*)d_in[5]; a.norm_g = (const float*)d_in[6]; a.w_ada = (const float*)d_in[7]; a.b_ada = (const float*)d_in[8];
    a.w_in = (const float*)d_in[9]; a.q_g = (const float*)d_in[10]; a.k_g = (const float*)d_in[11]; a.rpb = (const float*)d_in[12]; a.w_fnet = (const float*)d_in[13];
    a.w_pool = (const float*)d_in[14]; a.pool_scale = (const float*)d_in[15]; a.p_a = (const float*)d_in[16]; a.p_b = (const float*)d_in[17]; a.p_c = (const float*)d_in[18]; a.w_o = (const float*)d_in[19];
    a.out = (float*)d_out; a.ws = (unsigned char*)d_ws;
#if MK_SINGLE
    if (hipMemsetAsync((char*)d_ws + WS_BAR, 0, ZERO_BYTES, stream) != hipSuccess) { fprintf(stderr, "kernel_launch: memset of the barrier words failed\n"); return; }
    if (hipMemsetAsync((char*)d_ws + WS_ADA, 0, 2ull * 5 * 3072 * 4, stream) != hipSuccess) { fprintf(stderr, "kernel_launch: memset of ADA failed\n"); return; }
    a.ph_lo = 0; a.ph_hi = 14;
    void* args[] = {&a};
    hipError_t e = hipLaunchCooperativeKernel((const void*)mk_fwd, dim3(grid), dim3(512), args, LDS_BYTES, stream);
    if (e != hipSuccess) fprintf(stderr, "cooperative launch failed: %s (grid %d)\n", hipGetErrorString(e), grid);
#else
    for (int p = 0; p < 14; ++p) {
        a.ph_lo = p; a.ph_hi = p + 1;
        hipLaunchKernelGGL(mk_fwd, dim3(grid), dim3(512), LDS_BYTES, stream, a);
    }
#endif
}
```

```cpp
#include <hip/hip_runtime.h>
#include <hip/hip_cooperative_groups.h>
#include <cstdio>
#include <cstdint>
namespace cg = cooperative_groups;

#ifndef MK_SINGLE
#define MK_SINGLE 1
#endif

#define LAS __attribute__((address_space(3)))
typedef unsigned short bf16_t;
typedef short bf16x8 __attribute__((ext_vector_type(8)));
typedef short s16x4 __attribute__((ext_vector_type(4)));
typedef float f32x2 __attribute__((ext_vector_type(2)));
typedef float f32x4 __attribute__((ext_vector_type(4)));
typedef float f32x16 __attribute__((ext_vector_type(16)));
typedef unsigned u32x2 __attribute__((ext_vector_type(2)));
typedef unsigned u32x4 __attribute__((ext_vector_type(4)));
typedef __bf16 bf16x2_t __attribute__((ext_vector_type(2)));

#define DI __device__ __forceinline__
#define LAUNDER() asm volatile("" : "+v"(fr), "+v"(fq), "+s"(wr), "+s"(wc))

DI int otid() { int t = threadIdx.x; asm volatile("" : "+v"(t)); return t; }
DI unsigned pk2(float lo, float hi) { f32x2 v = {lo, hi}; bf16x2_t b = __builtin_convertvector(v, bf16x2_t); return __builtin_bit_cast(unsigned, b); }
DI float bflo(unsigned w) { return __uint_as_float(w << 16); }
DI float bfhi(unsigned w) { return __uint_as_float(w & 0xffff0000u); }
DI u32x4 pk8(const float* v) { u32x4 w; w.x = pk2(v[0], v[1]); w.y = pk2(v[2], v[3]); w.z = pk2(v[4], v[5]); w.w = pk2(v[6], v[7]); return w; }
DI float sigmoidf_(float v) { return __builtin_amdgcn_rcpf(1.0f + __builtin_amdgcn_exp2f(-1.4426950408889634f * v)); }

constexpr int T = 12288, TP = 4096, TS = 8192, DM = 1024, INW = 6144;
constexpr float LOG2E = 1.4426950408889634f;
constexpr float EPS = 1e-6f;

constexpr size_t WS_ADAP = 0;
constexpr size_t WS_ADA  = WS_ADAP + 16ull * 2 * 5 * 3072 * 4;
constexpr size_t WS_MCS  = WS_ADA + 2ull * 5 * 3072 * 4;
constexpr size_t WS_WIN  = WS_MCS + 2ull * 2 * 256 * 256 * 4;
constexpr size_t WIN_L   = 6400ull * 1024 * 2;
constexpr size_t WS_PT   = WS_WIN + 2 * WIN_L;
constexpr size_t WS_WO   = WS_PT + 2ull * 1024 * 1024 * 2;
constexpr size_t WS_DS   = WS_WO + 2ull * 1024 * 1024 * 2;
constexpr size_t WS_DP   = WS_DS + 2048ull * 4096 * 2;
constexpr size_t WS_CK   = WS_DP + 256ull * 4096 * 2;
constexpr size_t WS_CV   = WS_CK + 4ull * 2 * 8 * 256 * 64 * 2;
constexpr size_t WS_XH   = WS_CV + 4ull * 2 * 8 * 256 * 64 * 2;
constexpr size_t YBP_BYTES = 8ull * 8192 * 256 * 2 + 4096ull * 256 * 2;
constexpr size_t WS_QB   = WS_XH + YBP_BYTES;
constexpr size_t WS_KB   = WS_QB + (size_t)T * 512 * 2;
constexpr size_t WS_VB   = WS_KB + (size_t)T * 512 * 2;
constexpr size_t WS_VTS  = WS_VB + (size_t)T * 512 * 2;
constexpr size_t WS_VTP  = WS_VTS + 2ull * 256 * 8192 * 2;
constexpr size_t WS_G    = WS_VTP + 256ull * 8192 * 2;
constexpr size_t WS_UC   = WS_G + (size_t)T * 1024 * 2;
constexpr size_t WS_SG   = WS_UC + (size_t)T * 256 * 2;
constexpr size_t WS_BAR  = WS_SG + 3ull * T * 1024 * 2;
constexpr size_t WS_RSS  = WS_BAR + 16384;
constexpr size_t WS_SW   = WS_RSS + (size_t)T * 4;
constexpr size_t WS_Y1K  = WS_SW + 5ull * 6400 * 4;
constexpr size_t WS_END  = WS_Y1K + 4ull * 256 * 4;
constexpr size_t ZERO_BYTES = 16384 + (size_t)T * 4;
static_assert(WS_END <= 268435456ull, "workspace");

constexpr int LDS_RING = 131072;
constexpr int LDS_BYTES = LDS_RING + 16;

namespace pg8 {
constexpr int BM = 256, BK = 64, HALF = 128, HTB = HALF * BK * 2;
DI int lds_byte(int r, int c) { const int st = (r >> 4) * 2 + (c >> 5), rr = r & 15, cc = c & 31, ob = rr * 64 + cc * 2; return st * 1024 + (ob ^ (((ob >> 9) & 1) << 5)); }
DI void stage_rc(int b, int& R, int& C) { const int st = b / 1024, sb = b % 1024, swz = sb ^ (((sb >> 9) & 1) << 5); R = (st >> 1) * 16 + swz / 64; C = (st & 1) * 32 + (swz % 64) / 2; }
struct Unit { const char* a; const char* b; int k0, k1, k2, k3; };

struct NoHook { static constexpr bool ENABLED = false; DI void operator()(f32x4 (&)[2][2][4][2], const Unit&, int, int, int, int, int) const {} };
template <class Epi, class Sched, class Hook = NoHook>
DI void gemm_phase(LAS unsigned char* lds, const int pitchA, const int pitchB, const int nt, const Sched& S, const Epi& E, const Hook& H = Hook()) {
    const int tid = otid(), wid = __builtin_amdgcn_readfirstlane(tid >> 6), lane = tid & 63, wr = wid >> 2, wc = wid & 3, fr = lane & 15, fq = lane >> 4;
    unsigned voffA[2], voffB[2];
#pragma unroll
    for (int i = 0; i < 2; ++i) { int R, C; stage_rc(tid * 16 + i * 8192, R, C); voffA[i] = (unsigned)(R * pitchA + C) * 2u; voffB[i] = (unsigned)(R * pitchB + C) * 2u; }
    const size_t kstep = (size_t)(BK * 2);
    const size_t hstepA = (size_t)HALF * pitchA * 2, hstepB = (size_t)HALF * pitchB * 2;
    const unsigned ldsw = (unsigned)wid * 1024u;
    const int aoff = lds_byte(wr * 64 + fr, fq * 8), boff = lds_byte(wc * 32 + fr, fq * 8);
#define PG8_SA(b, h) (((b) * 2 + (h)) * HTB)
#define PG8_SB(b, h) ((4 + (b) * 2 + (h)) * HTB)
#define PG8_STAGE(bufoff, gbase, voff) do { _Pragma("unroll") for (int _i = 0; _i < 2; ++_i) \
        __builtin_amdgcn_global_load_lds((const unsigned*)((const char*)(gbase) + (voff)[_i]), (LAS unsigned*)(lds + (bufoff) + ldsw + _i * 8192), 16, 0, 0); } while (0)
#define PG8_LDA(dst, b, h) do { _Pragma("unroll") for (int m = 0; m < 4; ++m) _Pragma("unroll") for (int k = 0; k < 2; ++k) dst[m][k] = *(const LAS bf16x8*)(lds + PG8_SA(b, h) + aoff + m * 2048 + k * 1024); } while (0)
#define PG8_LDB(dst, b, h) do { _Pragma("unroll") for (int n = 0; n < 2; ++n) _Pragma("unroll") for (int k = 0; k < 2; ++k) dst[n][k] = *(const LAS bf16x8*)(lds + PG8_SB(b, h) + boff + n * 2048 + k * 1024); } while (0)
#define PG8_MMA(ai, bj, At, Bt) do { __builtin_amdgcn_s_setprio(1); _Pragma("unroll") for (int m = 0; m < 4; ++m) _Pragma("unroll") for (int n = 0; n < 2; ++n) _Pragma("unroll") for (int k = 0; k < 2; ++k) \
        acc[ai][bj][m][n] = __builtin_amdgcn_mfma_f32_16x16x32_bf16(Bt[n][k], At[m][k], acc[ai][bj][m][n], 0, 0, 0); __builtin_amdgcn_s_setprio(0); } while (0)
#define PG8_WAIT_V(n) asm volatile("s_waitcnt vmcnt(" #n ")" ::: "memory")
#define PG8_WAIT_L(n) asm volatile("s_waitcnt lgkmcnt(" #n ")" ::: "memory")
#define PG8_BAR __builtin_amdgcn_s_barrier()
#define PG8_SCHED __builtin_amdgcn_sched_barrier(0)
    Unit cur, nxt; int ui = 0;
    if (!S.next(0, cur)) return;
    f32x4 acc[2][2][4][2];
#pragma unroll
    for (int a = 0; a < 2; ++a)
#pragma unroll
        for (int b = 0; b < 2; ++b)
#pragma unroll
            for (int m = 0; m < 4; ++m)
#pragma unroll
                for (int n = 0; n < 2; ++n) acc[a][b][m][n] = (f32x4){0.f, 0.f, 0.f, 0.f};
    bf16x8 At[4][2], B0[2][2], B1[2][2];
    const char* cA = cur.a; const char* cB = cur.b;
    PG8_STAGE(PG8_SB(0, 0), cB, voffB); PG8_STAGE(PG8_SB(0, 1), cB + hstepB, voffB); PG8_STAGE(PG8_SA(0, 0), cA, voffA); PG8_STAGE(PG8_SA(0, 1), cA + hstepA, voffA);
    if (wr == 1) PG8_BAR;
    PG8_WAIT_V(2); PG8_BAR;
    PG8_STAGE(PG8_SB(1, 0), cB + kstep, voffB); PG8_STAGE(PG8_SA(1, 0), cA + kstep, voffA); PG8_STAGE(PG8_SB(1, 1), cB + hstepB + kstep, voffB);
    PG8_WAIT_V(6); PG8_BAR;
    for (;;) {
        const bool has_next = S.next(ui + 1, nxt);
        const char* nA = has_next ? nxt.a : cA; const char* nB = has_next ? nxt.b : cB;
        for (int t = 0; t < nt; t += 2) {
            const bool last = (t == nt - 2);
            if constexpr (Hook::ENABLED) { if (t == 8 || t == 12) { int le = lane; asm volatile("" : "+v"(le)); H(acc, cur, t, wr, wc, le & 15, le >> 4); } }
            const char* a1 = cA + (size_t)(t + 1) * kstep;
            const char* a2 = last ? nA : cA + (size_t)(t + 2) * kstep; const char* b2 = last ? nB : cB + (size_t)(t + 2) * kstep;
            const char* a3 = a2 + kstep; const char* b3 = b2 + kstep;
            PG8_LDB(B0, 0, 0); PG8_LDB(B1, 0, 1); PG8_SCHED; PG8_LDA(At, 0, 0); PG8_STAGE(PG8_SA(1, 1), a1 + hstepA, voffA);
            PG8_WAIT_V(8); PG8_WAIT_L(0); PG8_BAR; PG8_MMA(0, 0, At, B0); PG8_MMA(0, 1, At, B1); PG8_BAR; PG8_SCHED;
            PG8_LDA(At, 0, 1); PG8_STAGE(PG8_SB(0, 0), b2, voffB); PG8_STAGE(PG8_SB(0, 1), b2 + hstepB, voffB); PG8_STAGE(PG8_SA(0, 0), a2, voffA);
            PG8_WAIT_V(8); PG8_WAIT_L(0); PG8_BAR; PG8_MMA(1, 0, At, B0); PG8_MMA(1, 1, At, B1); PG8_BAR; PG8_SCHED;
            PG8_LDB(B0, 1, 0); PG8_LDB(B1, 1, 1); PG8_SCHED; PG8_LDA(At, 1, 0); PG8_STAGE(PG8_SA(0, 1), a2 + hstepA, voffA);
            PG8_WAIT_V(8); PG8_WAIT_L(0); PG8_BAR; PG8_MMA(0, 0, At, B0); PG8_MMA(0, 1, At, B1); PG8_BAR; PG8_SCHED;
            PG8_LDA(At, 1, 1); PG8_STAGE(PG8_SB(1, 0), b3, voffB); PG8_STAGE(PG8_SB(1, 1), b3 + hstepB, voffB); PG8_STAGE(PG8_SA(1, 0), a3, voffA);
            PG8_WAIT_V(8); PG8_WAIT_L(0); PG8_BAR; PG8_MMA(1, 0, At, B0); PG8_MMA(1, 1, At, B1); PG8_BAR; PG8_SCHED;
        }
        if (wr == 0) PG8_BAR;
        { int le = lane; asm volatile("" : "+v"(le)); E(acc, cur, wr, wc, le & 15, le >> 4); }
        if (!has_next) break;
#pragma unroll
        for (int a = 0; a < 2; ++a)
#pragma unroll
            for (int b = 0; b < 2; ++b)
#pragma unroll
                for (int m = 0; m < 4; ++m)
#pragma unroll
                    for (int n = 0; n < 2; ++n) acc[a][b][m][n] = (f32x4){0.f, 0.f, 0.f, 0.f};
        cur = nxt; cA = nA; cB = nB; ++ui;
        if (wr == 1) PG8_BAR;
    }
    PG8_WAIT_V(0);
    PG8_BAR;
#undef PG8_SA
#undef PG8_SB
#undef PG8_STAGE
#undef PG8_LDA
#undef PG8_LDB
#undef PG8_MMA
#undef PG8_WAIT_V
#undef PG8_WAIT_L
#undef PG8_BAR
#undef PG8_SCHED
}
}
using pg8::Unit;

#define XB_TMO      128
#define XB_XCNT(j)  (256  + 64 * (j))
#define XB_XSUB(j)  (1280 + 64 * (j))
#define XB_XGEN(j)  (2304 + 64 * (j))
#define XB_TOP      3328
#define XB_TOPGEN   3392
#define XCD_BAR_WORDS 3456
#define XB_SPIN_CAP (1u << 20)
DI unsigned xb_ld(unsigned* p)              { return __hip_atomic_load(p, __ATOMIC_RELAXED, __HIP_MEMORY_SCOPE_AGENT); }
DI unsigned xb_add(unsigned* p, unsigned v) { return __hip_atomic_fetch_add(p, v, __ATOMIC_RELAXED, __HIP_MEMORY_SCOPE_AGENT); }
DI unsigned xb_xcc_id() { return (unsigned)__builtin_amdgcn_s_getreg((3 << 11) | 20) & 0xFu; }
#define XB_SPIN(cond, bar) do { unsigned _sp = 0; while (cond) { __builtin_amdgcn_s_sleep(1); \
    if ((++_sp & 255u) == 0u) { if (xb_ld(&(bar)[XB_TMO])) break; if (_sp > XB_SPIN_CAP) { atomicAdd(&(bar)[XB_TMO], 1u); break; } } } } while (0)
struct XcdBarrier { unsigned* bar; unsigned x; volatile LAS unsigned* st; };
DI XcdBarrier xcd_barrier_post(unsigned* bar, volatile LAS unsigned* st) {
    XcdBarrier b; b.bar = bar; b.x = xb_xcc_id(); b.st = st;
    if (threadIdx.x == 0) (void)xb_add(&bar[XB_XCNT(b.x)], 1u);
    return b;
}
DI void xcd_barrier_complete(unsigned* bar, unsigned x, unsigned& nloc, unsigned& nx) {
    const unsigned G = gridDim.x * gridDim.y * gridDim.z;
    unsigned sum, cnt, mine, sp = 0u;
    for (;;) {
        sum = 0u; cnt = 0u; mine = 0u;
#pragma unroll
        for (unsigned j = 0; j < 16; ++j) { const unsigned c = xb_ld(&bar[XB_XCNT(j)]); sum += c; cnt += (c > 0u) ? 1u : 0u; mine = (j == x) ? c : mine; }
        if (sum == G) break;
        __builtin_amdgcn_s_sleep(1);
        if ((++sp & 255u) == 0u) { if (xb_ld(&bar[XB_TMO])) break; if (sp > XB_SPIN_CAP) { atomicAdd(&bar[XB_TMO], 1u); break; } }
    }
    nloc = mine > 0u ? mine : 1u; nx = cnt > 0u ? cnt : 1u;
}
DI void xcd_barrier(const XcdBarrier& b) {
    asm volatile("s_waitcnt vmcnt(0)" ::: "memory");
    __syncthreads();
    if (threadIdx.x == 0) {
        unsigned* bar = b.bar;
        __builtin_amdgcn_s_waitcnt(0);
        unsigned nloc = b.st[0], nx = b.st[1];
        if (nloc == 0u) { xcd_barrier_complete(bar, b.x, nloc, nx); b.st[0] = nloc; b.st[1] = nx; }
        const unsigned old = xb_add(&bar[XB_XSUB(b.x)], 1u);
        const unsigned gen = old / nloc;
        if (old + 1u == (gen + 1u) * nloc) {
            __builtin_amdgcn_fence(__ATOMIC_RELEASE, "agent");
            asm volatile("s_waitcnt vmcnt(0)" ::: "memory");
            const unsigned og = xb_add(&bar[XB_TOP], 1u);
            const unsigned tg = og / nx;
            if (og + 1u == (tg + 1u) * nx) xb_add(&bar[XB_TOPGEN], 1u);
            else XB_SPIN(xb_ld(&bar[XB_TOPGEN]) == tg, bar);
            __builtin_amdgcn_fence(__ATOMIC_ACQUIRE, "agent");
            xb_add(&bar[XB_XGEN(b.x)], 1u);
            asm volatile("s_waitcnt vmcnt(0)" ::: "memory");
        } else {
            XB_SPIN(xb_ld(&bar[XB_XGEN(b.x)]) == gen, bar);
            __builtin_amdgcn_fence(__ATOMIC_ACQUIRE, "agent");
            asm volatile("s_waitcnt vmcnt(0)" ::: "memory");
        }
    }
    __syncthreads();
}

struct Args {
    const float* x_prompt; const float* x_sample; const float* cache_k; const float* cache_v; const float* c; const float* c_ctx;
    const float* norm_g; const float* w_ada; const float* b_ada; const float* w_in; const float* q_g; const float* k_g; const float* rpb;
    const float* w_fnet; const float* w_pool; const float* pool_scale; const float* p_a; const float* p_b; const float* p_c; const float* w_o;
    float* out; unsigned char* ws; int ph_lo, ph_hi;
};

typedef const __attribute__((address_space(4))) Args* KArgP;
DI Args load_args(KArgP p) {
    Args a;
    a.x_prompt = p->x_prompt; a.x_sample = p->x_sample; a.cache_k = p->cache_k; a.cache_v = p->cache_v; a.c = p->c; a.c_ctx = p->c_ctx;
    a.norm_g = p->norm_g; a.w_ada = p->w_ada; a.b_ada = p->b_ada; a.w_in = p->w_in; a.q_g = p->q_g; a.k_g = p->k_g; a.rpb = p->rpb;
    a.w_fnet = p->w_fnet; a.w_pool = p->w_pool; a.pool_scale = p->pool_scale; a.p_a = p->p_a; a.p_b = p->p_b; a.p_c = p->p_c; a.w_o = p->w_o;
    a.out = p->out; a.ws = p->ws; a.ph_lo = p->ph_lo; a.ph_hi = p->ph_hi;
    return a;
}

DI void ada_task(const Args& A, int task, int lane, bool direct) {
    float* adap = (float*)(A.ws + WS_ADAP);
    {
        const int ng = task % 48, kc = (task / 48) & 15, l = task / 768;
        const int k = kc * 64 + lane;
        float sv[5];
        { const float v = A.c_ctx[k]; sv[0] = v * sigmoidf_(v); }
#pragma unroll
        for (int j = 1; j < 5; ++j) { const float v = A.c[(j - 1) * 1024 + k]; sv[j] = v * sigmoidf_(v); }
        float acc[5] = {0.f, 0.f, 0.f, 0.f, 0.f};
        const float* wp = A.w_ada + ((size_t)l * 1024 + kc * 64) * 3072 + ng * 64 + lane;
#pragma unroll 16
        for (int kk = 0; kk < 64; ++kk) {
            const float w = __builtin_nontemporal_load(wp + (size_t)kk * 3072);
#pragma unroll
            for (int j = 0; j < 5; ++j) acc[j] += __shfl(sv[j], kk) * w;
        }
#pragma unroll
        for (int j = 0; j < 5; ++j) {
            if (direct) atomicAdd((float*)(A.ws + WS_ADA) + (size_t)(l * 5 + j) * 3072 + ng * 64 + lane, acc[j] + (kc == 0 ? A.b_ada[l * 3072 + ng * 64 + lane] : 0.f));
            else adap[((size_t)(kc * 2 + l) * 5 + j) * 3072 + ng * 64 + lane] = acc[j];
        }
    }
}

DI int prow(int L) { return (L & ~31) | (16 * ((L >> 2) & 1) + 4 * ((L >> 3) & 3) + (L & 3)); }
DI int pcol(int p) { return (p & ~31) | (8 * ((p >> 2) & 3) + 4 * ((p >> 4) & 1) + (p & 3)); }
DI int win_row(int n) {
    if (n < 1536) { const int pn = n >> 8, l = n & 255, wc = l >> 6, bj = (l >> 5) & 1, o = l & 31; return pn * 256 + 128 * bj + 32 * wc + o; }
    if (n < 2048) return n;
    if (n < 2304) return -1;
    if (n < 2560) return 2048 + (n - 2304);
    if (n < 2816) return -1;
    if (n < 3072) return 2560 + (n - 2816);
    return 2816 + (n - 3072);
}
template <bool WIN>
DI void transpose_task(const float* src, int K, int N, bf16_t* dst, int dp, int coloff, int wt, int lane) {
    const int nch = N >> 6; const int n = (wt % nch) * 64 + lane, kb = wt / nch;
    const int row0 = WIN ? win_row(n) : n;
    if (row0 < 0) return;
    const int row = prow(row0);
    const float* sp = src + (size_t)(kb * 64) * N + n;
    bf16_t* dq = dst + (size_t)row * dp + coloff + kb * 64;
#pragma unroll 4
    for (int k8 = 0; k8 < 8; ++k8) {
        float v[8];
#pragma unroll
        for (int i = 0; i < 8; ++i) v[i] = __builtin_nontemporal_load(sp + (size_t)(k8 * 8 + i) * N);
        *(u32x4*)(dq + k8 * 8) = pk8(v);
    }
}

DI void fold_pool_task(const Args& A, int task, int lane, LAS float* wl) {
    {
        const int k8 = task & 127, g = (task >> 7) & 3, l = task >> 9;
        const float* wi = A.w_in + (size_t)l * 1024 * INW + (size_t)(k8 * 8) * INW + 2560 + g * 64;
        const float* wp = A.w_pool + ((size_t)(l * 4 + g) * 64) * 64 + lane;
        float acc[8] = {0.f, 0.f, 0.f, 0.f, 0.f, 0.f, 0.f, 0.f};
        {
            float rw[8];
#pragma unroll
            for (int i = 0; i < 8; ++i) rw[i] = wi[(size_t)i * INW + lane];
#pragma unroll
            for (int i = 0; i < 8; ++i) wl[i * 64 + lane] = rw[i];
            asm volatile("" ::: "memory");
        }
#pragma unroll 16
        for (int cc = 0; cc < 64; ++cc) {
            const float p = wp[cc * 64];
#pragma unroll
            for (int i = 0; i < 8; ++i) acc[i] += wl[i * 64 + cc] * p;
        }
        asm volatile("" ::: "memory");
        const float sc = A.pool_scale[l * 256 + g * 64 + lane];
#pragma unroll
        for (int i = 0; i < 8; ++i) acc[i] *= sc;
        bf16_t* dst = (bf16_t*)(A.ws + WS_WIN + (size_t)l * WIN_L) + (size_t)(2304 + prow(g * 64 + lane)) * 1024 + k8 * 8;
        *(u32x4*)dst = pk8(acc);
    }
}

DI void mcs_task(const Args& A, int task, int lane, const LAS f32x2* tbl) {
    float* M = (float*)(A.ws + WS_MCS);
    {
        const int eg = task & 3, m = (task >> 2) & 255, l = task >> 10;
        const int g = m >> 6, n2 = m & 63, e = eg * 64 + lane;
        const float* wf = A.w_fnet + ((size_t)l * 256 + g * 64) * 256 + e;
        float ac = 0.f, as = 0.f;
#pragma unroll 8
        for (int k2 = 0; k2 < 64; ++k2) {
            const f32x2 cs_ = tbl[((n2 * k2) & 63) * 32];
            const float w = wf[(size_t)k2 * 256];
            ac += cs_.x * w; as += cs_.y * w;
        }
        M[((size_t)(l * 2 + 0) * 256 + m) * 256 + e] = ac;
        M[((size_t)(l * 2 + 1) * 256 + m) * 256 + e] = as;
    }
}

DI void dft_task(const Args& A, int task, const LAS f32x2* tbl) {
    bf16_t* DS = (bf16_t*)(A.ws + WS_DS); bf16_t* DP = (bf16_t*)(A.ws + WS_DP);
    const float ss = 1.0f / sqrtf(2048.0f * 64.0f), sp = 1.0f / 128.0f;
    {
        float cv[8], sv[8];
        if (task < 1024 * 256) {
            const int k1 = task >> 8, n0 = (task & 255) * 8;
#pragma unroll
            for (int i = 0; i < 8; ++i) { const f32x2 cs_ = tbl[(k1 * (n0 + i)) & 2047]; cv[i] = cs_.x * ss; sv[i] = -cs_.y * ss; }
            *(u32x4*)(DS + ((size_t)((n0 >> 9) * 1024 + k1)) * 512 + (n0 & 511)) = pk8(cv); *(u32x4*)(DS + ((size_t)((4 + (n0 >> 9)) * 1024 + k1)) * 512 + (n0 & 511)) = pk8(sv);
        } else {
            const int t2 = task - 1024 * 256; const int k1 = t2 >> 5, n0 = (t2 & 31) * 8;
#pragma unroll
            for (int i = 0; i < 8; ++i) { const f32x2 cs_ = tbl[((k1 * (n0 + i)) & 255) * 8]; cv[i] = cs_.x * sp; sv[i] = -cs_.y * sp; }
            *(u32x4*)(DP + (size_t)k1 * 512 + n0) = pk8(cv); *(u32x4*)(DP + (size_t)k1 * 512 + 256 + n0) = pk8(sv);
        }
    }
}

DI void cache_task(const Args& A, int task) {
    bf16_t* CK = (bf16_t*)(A.ws + WS_CK); bf16_t* CV = (bf16_t*)(A.ws + WS_CV);
    {
        const int which = task >> 17, i8 = (task & 131071) * 8;
        const float* s = (which ? A.cache_v : A.cache_k) + i8;
        const f32x4 a = __builtin_nontemporal_load((const f32x4*)s), b = __builtin_nontemporal_load((const f32x4*)(s + 4));
        u32x4 w; w.x = pk2(a[0], a[1]); w.y = pk2(a[2], a[3]); w.z = pk2(b[0], b[1]); w.w = pk2(b[2], b[3]);
        *(u32x4*)((which ? CV : CK) + i8) = w;
    }
}

DI void phase_a(const Args& A, bool direct, LAS unsigned char* lds) {
    const int tid = otid(), lane = tid & 63;
    LAS f32x2* tbl = (LAS f32x2*)lds;
    for (int i = tid; i < 2048; i += blockDim.x) { const float a = (float)i * (1.0f / 1024.0f); tbl[i] = (f32x2){cospif(a), sinpif(a)}; }
    __syncthreads();
    LAS float* wl = (LAS float*)(lds + 16384 + (tid >> 6) * 2048);
    const int gw = __builtin_amdgcn_readfirstlane((blockIdx.x * blockDim.x + tid) >> 6), GW = (gridDim.x * blockDim.x) >> 6;
    constexpr int N_ADA = 1536, N_FP = 1024, N_MCS = 2048, N_WIN = 2 * 1536, N_WO = 2 * 256, N_PA = 2 * 128, N_PB = 2 * 64, N_PC = 2 * 64, N_CACHE = 4096, N_DFT = 4224;
    constexpr int E0 = N_ADA, E1 = E0 + N_FP, E2 = E1 + N_MCS, E3 = E2 + N_WIN, E4 = E3 + N_WO, E5 = E4 + N_PA, E6 = E5 + N_PB, E7 = E6 + N_PC, E8 = E7 + N_CACHE, E9 = E8 + N_DFT;
    for (int id = gw; id < E9; id += GW) {
        if (id < E0) ada_task(A, id, lane, direct);
        else if (id < E1) fold_pool_task(A, id - E0, lane, wl);
        else if (id < E2) mcs_task(A, id - E1, lane, tbl);
        else if (id < E3) { const int w = id - E2, l = w / 1536; transpose_task<true>(A.w_in + (size_t)l * 1024 * INW, 1024, INW, (bf16_t*)(A.ws + WS_WIN + (size_t)l * WIN_L), 1024, 0, w % 1536, lane); }
        else if (id < E4) { const int w = id - E3, l = w / 256; transpose_task<false>(A.w_o + (size_t)l * 1024 * 1024, 1024, 1024, (bf16_t*)(A.ws + WS_WO) + (size_t)l * 1024 * 1024, 1024, 0, w % 256, lane); }
        else if (id < E5) { const int w = id - E4, l = w / 128; transpose_task<false>(A.p_a + (size_t)l * 512 * 1024, 512, 1024, (bf16_t*)(A.ws + WS_PT) + (size_t)l * 1024 * 1024, 1024, 0, w % 128, lane); }
        else if (id < E6) { const int w = id - E5, l = w / 64; transpose_task<false>(A.p_b + (size_t)l * 256 * 1024, 256, 1024, (bf16_t*)(A.ws + WS_PT) + (size_t)l * 1024 * 1024, 1024, 512, w % 64, lane); }
        else if (id < E7) { const int w = id - E6, l = w / 64; transpose_task<false>(A.p_c + (size_t)l * 256 * 1024, 256, 1024, (bf16_t*)(A.ws + WS_PT) + (size_t)l * 1024 * 1024, 1024, 768, w % 64, lane); }
        else if (id < E8) cache_task(A, (id - E7) * 64 + lane);
        else dft_task(A, (id - E8) * 64 + lane, tbl);
    }
}

DI void phase_b(const Args& A, LAS unsigned char* lds, bool direct) {
    const int tid = otid(), lane = tid & 63;
    const int gt = blockIdx.x * blockDim.x + tid, GT = gridDim.x * blockDim.x;
    const int gw = __builtin_amdgcn_readfirstlane(gt >> 6), GW = GT >> 6;
    const float* adap = (const float*)(A.ws + WS_ADAP); float* ada = (float*)(A.ws + WS_ADA);
    if (!direct) for (int i = gt; i < 2 * 5 * 3072; i += GT) {
        const int n = i % 3072, l = i / (5 * 3072);
        float s = A.b_ada[l * 3072 + n];
#pragma unroll
        for (int kc = 0; kc < 16; ++kc) s += adap[(size_t)kc * (2 * 5 * 3072) + i];
        ada[i] = s;
    }
    const float* M = (const float*)(A.ws + WS_MCS);
    LAS float* wl = (LAS float*)(lds + (tid >> 6) * 8192);
    for (int task = gw; task < 2048; task += GW) {
        const int k8 = task & 127, eg = (task >> 7) & 3, s = (task >> 9) & 1, l = task >> 10;
        const float* wi = A.w_in + (size_t)l * 1024 * INW + (size_t)(k8 * 8) * INW + 2048;
        const float* mp = M + ((size_t)(l * 2 + s) * 256) * 256 + eg * 64 + lane;
        f32x4 rw[8];
#pragma unroll
        for (int i = 0; i < 8; ++i) rw[i] = *(const f32x4*)(wi + (size_t)i * INW + lane * 4);
#pragma unroll
        for (int i = 0; i < 8; ++i) *(LAS f32x4*)(wl + i * 256 + lane * 4) = rw[i];
        asm volatile("" ::: "memory");
        float acc[8] = {0.f, 0.f, 0.f, 0.f, 0.f, 0.f, 0.f, 0.f};
#pragma unroll 16
        for (int m = 0; m < 256; ++m) {
            const float mv = mp[(size_t)m * 256];
#pragma unroll
            for (int i = 0; i < 8; ++i) acc[i] += wl[i * 256 + m] * mv;
        }
        asm volatile("" ::: "memory");
        bf16_t* dst = (bf16_t*)(A.ws + WS_WIN + (size_t)l * WIN_L) + (size_t)(5888 + s * 256 + prow(eg * 64 + lane)) * 1024 + k8 * 8;
        *(u32x4*)dst = pk8(acc);
    }
}

DI const float* x_row(const Args& A, int l, int t) {
    if (l == 0) return t < TP ? A.x_prompt + (size_t)t * 1024 : A.x_sample + (size_t)(t - TP) * 1024;
    return A.out + (size_t)t * 1024;
}
DI int cond_of(int t) { return t < TP ? 0 : 1 + ((t - TP) >> 11); }

DI void sw_tasks(const Args& A, int gw, int GW, int lane) {
    const float* ada = (const float*)(A.ws + WS_ADA);
    {
        float sh[5][16];
#pragma unroll
        for (int j = 0; j < 5; ++j)
#pragma unroll
            for (int q = 0; q < 4; ++q) { const f32x4 v = *(const f32x4*)(ada + (size_t)(5 + j) * 3072 + lane * 16 + q * 4); sh[j][4 * q] = v[0]; sh[j][4 * q + 1] = v[1]; sh[j][4 * q + 2] = v[2]; sh[j][4 * q + 3] = v[3]; }
        const bf16_t* W1 = (const bf16_t*)(A.ws + WS_WIN + WIN_L); float* SW = (float*)(A.ws + WS_SW);
        for (int n = gw; n < 6400; n += GW) {
            const u32x4 w0 = *(const u32x4*)(W1 + (size_t)n * 1024 + lane * 16), w1 = *(const u32x4*)(W1 + (size_t)n * 1024 + lane * 16 + 8);
            const float wv[16] = {bflo(w0.x), bfhi(w0.x), bflo(w0.y), bfhi(w0.y), bflo(w0.z), bfhi(w0.z), bflo(w0.w), bfhi(w0.w), bflo(w1.x), bfhi(w1.x), bflo(w1.y), bfhi(w1.y), bflo(w1.z), bfhi(w1.z), bflo(w1.w), bfhi(w1.w)};
#pragma unroll
            for (int j = 0; j < 5; ++j) {
                float a = 0.f;
#pragma unroll
                for (int q = 0; q < 16; ++q) a += sh[j][q] * wv[q];
#pragma unroll
                for (int o = 32; o >= 1; o >>= 1) a += __shfl_xor(a, o);
                if (lane == 0) SW[j * 6400 + n] = a;
            }
        }
    }
}

DI void phase_norm(const Args& A, int l, bool do_sw) {
    const int tid = otid(), lane = tid & 63;
    const int gw = __builtin_amdgcn_readfirstlane((blockIdx.x * blockDim.x + tid) >> 6), GW = (gridDim.x * blockDim.x) >> 6;
    const float* ada = (const float*)(A.ws + WS_ADA);
    if (l == 0 && do_sw) sw_tasks(A, gw, GW, lane);
    bf16_t* XH = (bf16_t*)(A.ws + WS_XH);
    for (int t0 = gw; t0 < T; t0 += 6 * GW) {
        f32x4 v[6][4]; float ss[6];
#pragma unroll
        for (int q = 0; q < 6; ++q) {
            const int t = min(t0 + q * GW, T - 1);
            const float* xr = x_row(A, l, t);
#pragma unroll
            for (int i = 0; i < 4; ++i) v[q][i] = *(const f32x4*)(xr + i * 256 + lane * 4);
        }
#pragma unroll
        for (int q = 0; q < 6; ++q) {
            float a = 0.f;
#pragma unroll
            for (int i = 0; i < 4; ++i) a += v[q][i][0] * v[q][i][0] + v[q][i][1] * v[q][i][1] + v[q][i][2] * v[q][i][2] + v[q][i][3] * v[q][i][3];
#pragma unroll
            for (int o = 32; o >= 1; o >>= 1) a += __shfl_xor(a, o);
            ss[q] = rsqrtf(a * (1.0f / 1024.0f) + EPS);
        }
#pragma unroll
        for (int q = 0; q < 6; ++q) {
            const int t = t0 + q * GW;
            if (t < T) {
                const int j = cond_of(t);
                const float* sh = ada + (size_t)(l * 5 + j) * 3072; const float* sc = sh + 1024;
#pragma unroll
                for (int i = 0; i < 4; ++i) {
                    const int c0 = i * 256 + lane * 4;
                    const f32x4 g = *(const f32x4*)(A.norm_g + l * 1024 + c0), s1 = *(const f32x4*)(sc + c0), s0 = *(const f32x4*)(sh + c0);
                    float o[4];
#pragma unroll
                    for (int e = 0; e < 4; ++e) o[e] = v[q][i][e] * ss[q] * g[e] * (1.0f + s1[e]) + s0[e];
                    u32x2 w; w.x = pk2(o[0], o[1]); w.y = pk2(o[2], o[3]);
                    *(u32x2*)(XH + (size_t)t * 1024 + c0) = w;
                }
            }
        }
    }
}

constexpr size_t TILE1K = 256ull * 1024 * 2;
struct InSched {
    const char* XH; const char* W; int c, G;
    DI bool next(int i, Unit& u) const {
        int pm, pnn;
        if (G == 256) { const int xcd = c & 7, slot = c >> 3, j = i * 32 + slot; if (j >= 150) return false; pnn = (j / 6 + 23) % 25; pm = xcd * 6 + j % 6; }
        else { const int L = i * G + c; if (L >= 1200) return false; pm = L % 48; pnn = L / 48; }
        if (pnn < 23) { u.a = XH + (size_t)pm * TILE1K; u.b = W + (size_t)pnn * TILE1K; u.k0 = 0; u.k1 = pm; u.k2 = pnn; u.k3 = 0; }
        else { u.a = W + (size_t)pnn * TILE1K; u.b = XH + (size_t)pm * TILE1K; u.k0 = 1; u.k1 = pnn - 23; u.k2 = pm; u.k3 = 0; }
        return true;
    }
};
struct EpiIn {
    int l; int fused; unsigned char* ws; float* outk; const float* qg; const float* kg;
    DI void operator()(f32x4 (&acc)[2][2][4][2], const Unit& u, int wr, int wc, int fr, int fq) const {
        LAUNDER();
        bf16_t* const QB = (bf16_t*)(ws + WS_QB); bf16_t* const Gb = (bf16_t*)(ws + WS_G); bf16_t* const UC = (bf16_t*)(ws + WS_UC); bf16_t* const SG = (bf16_t*)(ws + WS_SG);
        bf16_t* const VTS = (bf16_t*)(ws + WS_VTS); bf16_t* const VTP = (bf16_t*)(ws + WS_VTP); const float* const rss = (const float*)(ws + WS_RSS); const float* const sw = (const float*)(ws + WS_SW);
        if (u.k0 == 0) {
            const int pm = u.k1, pn = u.k2;
            if (fused) {
                const float* swp = sw + (size_t)cond_of(256 * pm) * 6400 + 256 * pn + 32 * wc + 4 * fq;
                f32x4 sw4[2][2];
#pragma unroll
                for (int bj = 0; bj < 2; ++bj)
#pragma unroll
                    for (int n = 0; n < 2; ++n) sw4[bj][n] = *(const f32x4*)(swp + 128 * bj + 16 * n);
#pragma unroll
                for (int ai = 0; ai < 2; ++ai)
#pragma unroll
                    for (int m = 0; m < 4; ++m) {
                        const float rs = rsqrtf(rss[256 * pm + 128 * ai + 64 * wr + 16 * m + fr] * (1.0f / 1024.0f) + EPS);
#pragma unroll
                        for (int bj = 0; bj < 2; ++bj)
#pragma unroll
                            for (int n = 0; n < 2; ++n) acc[ai][bj][m][n] = acc[ai][bj][m][n] * rs + sw4[bj][n];
                    }
            }
#define VAL(ai, bj, m, n) (acc[ai][bj][m][n])
            if (pn < 6) {
                const int kind = pn >> 1, head = (pn & 1) * 4 + wc;
                bf16_t* buf = QB + (size_t)kind * ((size_t)T * 512);
                float* ob = outk + (size_t)(kind - 1) * (16ull * 2 * 8 * 256 * 64);
                const float* gp = kind == 0 ? qg : kg;
                const float qs = kind == 0 ? 0.125f * LOG2E : 1.0f;
                f32x4 gv[2][2];
#pragma unroll
                for (int bj = 0; bj < 2; ++bj)
#pragma unroll
                    for (int n = 0; n < 2; ++n) gv[bj][n] = kind < 2 ? *(const f32x4*)(gp + l * 64 + 32 * bj + 8 * fq + 4 * n) * qs : (f32x4){1.f, 1.f, 1.f, 1.f};
#pragma unroll
                for (int ai = 0; ai < 2; ++ai)
#pragma unroll
                    for (int m = 0; m < 4; ++m) {
                        const int r = 128 * ai + 64 * wr + 16 * m + fr; const int t = 256 * pm + r;
                        float rstd = 1.0f;
                        if (kind < 2) {
                            float ss = 0.f;
#pragma unroll
                            for (int bj = 0; bj < 2; ++bj)
#pragma unroll
                                for (int n = 0; n < 2; ++n) { const f32x4 v = VAL(ai, bj, m, n); ss += v[0] * v[0] + v[1] * v[1] + v[2] * v[2] + v[3] * v[3]; }
                            ss += __shfl_xor(ss, 16); ss += __shfl_xor(ss, 32);
                            rstd = rsqrtf(ss * (1.0f / 64.0f) + EPS);
                        }
#pragma unroll
                        for (int bj = 0; bj < 2; ++bj) {
                            const int d0 = 32 * bj + 8 * fq;
                            const f32x4 v0 = VAL(ai, bj, m, 0) * rstd * gv[bj][0], v1 = VAL(ai, bj, m, 1) * rstd * gv[bj][1];
                            u32x4 w; w.x = pk2(v0[0], v0[1]); w.y = pk2(v0[2], v0[3]); w.z = pk2(v1[0], v1[1]); w.w = pk2(v1[2], v1[3]);
                            *(u32x4*)(buf + (size_t)t * 512 + head * 64 + d0) = w;
                            if (kind >= 1 && pm < 16) { float* op = ob + ((size_t)((pm * 2 + l) * 8 + head) * 256 + r) * 64 + d0; *(f32x4*)op = v0; *(f32x4*)(op + 4) = v1; }
                        }
                    }
            } else {
                bf16_t* base; int ld, mode;
                if (pn < 9) { base = Gb + (pn - 6) * 256; ld = 1024; mode = 1; }
                else if (pn == 9) { base = UC; ld = 256; mode = 0; }
                else if (pn == 10) { base = Gb + 768; ld = 1024; mode = 1; }
                else {
                    bf16_t* tb = SG + ((size_t)(((pn - 11) >> 2) * 48 + pm) * 4 + ((pn - 11) & 3)) * 65536 + (size_t)((wr * 4 + wc) * 16 * 64 + fq * 16 + fr) * 8;
#pragma unroll
                    for (int ai = 0; ai < 2; ++ai)
#pragma unroll
                        for (int m = 0; m < 4; ++m)
#pragma unroll
                            for (int bj = 0; bj < 2; ++bj) {
                                float o[8];
#pragma unroll
                                for (int n = 0; n < 2; ++n) {
                                    const f32x4 v = VAL(ai, bj, m, n);
#pragma unroll
                                    for (int e = 0; e < 4; ++e) o[4 * n + e] = sigmoidf_(v[e]);
                                }
                                *(u32x4*)(tb + (size_t)(((ai * 4 + m) * 2 + bj) * 64) * 8) = pk8(o);
                            }
                    return;
                }
#pragma unroll
                for (int ai = 0; ai < 2; ++ai)
#pragma unroll
                    for (int m = 0; m < 4; ++m) {
                        const int r = 128 * ai + 64 * wr + 16 * m + fr;
                        bf16_t* rowp = base + (size_t)(256 * pm + r) * ld + 32 * wc + 8 * fq;
#pragma unroll
                        for (int bj = 0; bj < 2; ++bj) {
                            float o[8];
#pragma unroll
                            for (int n = 0; n < 2; ++n) {
                                const f32x4 v = VAL(ai, bj, m, n);
#pragma unroll
                                for (int e = 0; e < 4; ++e) { const float s = sigmoidf_(v[e]); o[4 * n + e] = mode == 0 ? v[e] : v[e] * s; }
                            }
                            *(u32x4*)(rowp + 128 * bj) = pk8(o);
                        }
                    }
            }
#undef VAL
        } else {
            const int s = u.k1, pt = u.k2;
            bf16_t* base;
            if (pt < 16) base = VTP + (size_t)pt * 256 * 512 + s * 256;
            else { const int ts0 = 256 * (pt - 16), b = ts0 >> 11, n10 = ts0 & 2047; base = VTS + ((size_t)(b * 8 + s * 4 + (n10 >> 9)) * 256) * 512 + (n10 & 511); }
            f32x4 rs4[2][2];
#pragma unroll
            for (int bj = 0; bj < 2; ++bj)
#pragma unroll
                for (int n = 0; n < 2; ++n) {
                    rs4[bj][n] = (f32x4){1.f, 1.f, 1.f, 1.f};
                    if (fused) { const f32x4 q = *(const f32x4*)(rss + 256 * pt + 128 * bj + 32 * wc + 16 * n + 4 * fq);
                        rs4[bj][n] = (f32x4){rsqrtf(q[0] * (1.0f / 1024.0f) + EPS), rsqrtf(q[1] * (1.0f / 1024.0f) + EPS), rsqrtf(q[2] * (1.0f / 1024.0f) + EPS), rsqrtf(q[3] * (1.0f / 1024.0f) + EPS)}; }
                }
            const float* swp = sw + (size_t)cond_of(256 * pt) * 6400 + 5888 + 256 * s;
#pragma unroll
            for (int ai = 0; ai < 2; ++ai)
#pragma unroll
                for (int m = 0; m < 4; ++m) {
                    const int r = 128 * ai + 64 * wr + 16 * m + fr;
                    const float swr = fused ? swp[r] : 0.f;
                    bf16_t* rowp = base + (size_t)r * 512 + 32 * wc + 4 * fq;
#pragma unroll
                    for (int bj = 0; bj < 2; ++bj)
#pragma unroll
                        for (int n = 0; n < 2; ++n) {
                            const f32x4 v = fused ? acc[ai][bj][m][n] * rs4[bj][n] + swr : acc[ai][bj][m][n];
                            u32x2 w; w.x = pk2(v[0], v[1]); w.y = pk2(v[2], v[3]);
                            *(u32x2*)(rowp + 128 * bj + 16 * n) = w;
                        }
                }
        }
    }
};

struct FourSched {
    const char* DS; const char* DP; const char* VTS; const char* VTP; int c, G;
    DI bool next(int i, Unit& u) const {
        const int f = i * G + c; if (f >= 144) return false;
        if (f < 128) { const int b = f >> 5, pm = (f >> 3) & 3, kc = f & 7;
            u.a = DS + ((size_t)(kc * 1024 + pm * 256) * 512) * 2; u.b = VTS + ((size_t)(b * 8 + kc) * 256 * 512) * 2; u.k0 = 0; u.k1 = b; u.k2 = pm; u.k3 = kc; }
        else { const int b = f - 128; u.a = DP; u.b = VTP + (size_t)b * 256 * 512 * 2; u.k0 = 1; u.k1 = b; u.k2 = 0; u.k3 = 0; }
        return true;
    }
};
struct EpiFour {
    bf16_t* YS; bf16_t* YP;
    DI void operator()(const f32x4 (&acc)[2][2][4][2], const Unit& u, int wr, int wc, int fr, int fq) const {
        LAUNDER();
        bf16_t* base = u.k0 == 0 ? YS + ((size_t)u.k3 * 8192 + u.k1 * 2048 + u.k2 * 256) * 256 : YP + (size_t)u.k1 * 256 * 256;
#pragma unroll
        for (int ai = 0; ai < 2; ++ai)
#pragma unroll
            for (int m = 0; m < 4; ++m) {
                const int r = 128 * ai + 64 * wr + 16 * m + fr;
                bf16_t* rowp = base + (size_t)r * 256 + 32 * wc + 8 * fq;
#pragma unroll
                for (int bj = 0; bj < 2; ++bj) {
                    const f32x4 v0 = acc[ai][bj][m][0], v1 = acc[ai][bj][m][1];
                    u32x4 w; w.x = pk2(v0[0], v0[1]); w.y = pk2(v0[2], v0[3]); w.z = pk2(v1[0], v1[1]); w.w = pk2(v1[2], v1[3]);
                    *(u32x4*)(rowp + 128 * bj) = w;
                }
            }
    }
};

DI int crow(int i, int hf) { return (i & 3) + 8 * (i >> 2) + 4 * hf; }
DI s16x4 tr_read(const LAS unsigned char* p) { return __builtin_bit_cast(s16x4, __builtin_amdgcn_ds_read_tr16_b64_v4i16((LAS s16x4*)p)); }

constexpr int VROW = 144, PBUF = 64 * VROW, STG = 2 * PBUF;
constexpr int RPB_LDS = 15360;

DI void attn_wg(const Args& A, int l, int kind, int b, int h, int r4, LAS unsigned char* lds, int wid, int lane, int tid, int dry) {
    const bf16_t* QB = (const bf16_t*)(A.ws + WS_QB); const bf16_t* KB = (const bf16_t*)(A.ws + WS_KB); const bf16_t* VB = (const bf16_t*)(A.ws + WS_VB);
    const bf16_t* CK = (const bf16_t*)(A.ws + WS_CK); const bf16_t* CV = (const bf16_t*)(A.ws + WS_CV);
    bf16_t* Gb = (bf16_t*)(A.ws + WS_G);
    const LAS float* rpbL = (const LAS float*)lds + 64 + h * 465;
    LAS unsigned char* sb = lds + RPB_LDS;
    const int r = lane & 31, hf = lane >> 5;
    int qtok, npair, rs = 0, rsU = 0, grow = 0, hq = 0;
    if (kind == 0) {
        grow = r4 * 4 + (wid >> 1); hq = wid & 1; qtok = TP + b * 2048 + grow * 64 + hq * 32 + r;
        rs = min(max(grow - 4, 0), 24); rsU = min(max(r4 * 4 - 4, 0), 24);
        const int rsL = min(max(r4 * 4 + 3 - 4, 0), 24);
        npair = 4 + (rsL + 8 - rsU);
    } else { qtok = b * 256 + wid * 32 + r; npair = 4; }
    const int qc = hq * 32 + r, cs = min(max(qc - 8, 0), 48);
    bf16x8 qf[4];
#pragma unroll
    for (int s = 0; s < 4; ++s) qf[s] = *(const bf16x8*)(QB + (size_t)qtok * 512 + h * 64 + 16 * s + 8 * hf);
    f32x16 o0, o1;
#pragma unroll
    for (int i = 0; i < 16; ++i) { o0[i] = 0.f; o1[i] = 0.f; }
    float mrun = -1e30f, lrun = 0.f;
    auto pair_ptrs = [&](int pi, const bf16_t*& kp, const bf16_t*& vp, int& pitch) {
        if (kind == 0) {
            if (pi < 4) { const size_t off = ((size_t)((b * 2 + l) * 8 + h) * 256 + 64 * pi) * 64; kp = CK + off; vp = CV + off; pitch = 64; }
            else { const size_t off = (size_t)(TP + b * 2048 + (rsU + pi - 4) * 64) * 512 + h * 64; kp = KB + off; vp = VB + off; pitch = 512; }
        } else { const size_t off = (size_t)(b * 256 + 64 * pi) * 512 + h * 64; kp = KB + off; vp = VB + off; pitch = 512; }
    };
    const int lrow = tid >> 3, lc16 = tid & 7;
    const int ldst = lrow * VROW + lc16 * 16;
    u32x4 kR[3], vR[3];
#define ATT_LOAD(J, P) do { if ((P) < npair) { const bf16_t* kp_; const bf16_t* vp_; int pitch_; pair_ptrs((P), kp_, vp_, pitch_); \
        kR[J] = *(const u32x4*)(kp_ + (size_t)lrow * pitch_ + lc16 * 8); vR[J] = *(const u32x4*)(vp_ + (size_t)lrow * pitch_ + lc16 * 8); } } while (0)
    ATT_LOAD(0, 0); ATT_LOAD(1, 1); ATT_LOAD(2, 2);
    __syncthreads();
    *(LAS u32x4*)(sb + ldst) = kR[0]; *(LAS u32x4*)(sb + PBUF + ldst) = vR[0];
    __syncthreads();
    for (int pi0 = 0; pi0 < npair; pi0 += 3) {
#pragma unroll
      for (int jj = 0; jj < 3; ++jj) {
        const int pi = pi0 + jj;
        if (pi < npair) {
        const bool more = pi + 1 < npair;
        if (jj == 0) ATT_LOAD(0, pi + 3); else if (jj == 1) ATT_LOAD(1, pi + 3); else ATT_LOAD(2, pi + 3);
        const int wrow = rsU + pi - 4;
        const bool mine = (kind != 0) || pi < 4 || (wrow >= rs && wrow < rs + 8);
        if (mine) {
            const LAS unsigned char* kb_ = sb + (pi & 1) * STG;
            const LAS unsigned char* vb_ = kb_ + PBUF;
            bf16x8 kf[2][4];
#pragma unroll
            for (int u = 0; u < 2; ++u)
#pragma unroll
                for (int s = 0; s < 4; ++s) kf[u][s] = *(const LAS bf16x8*)(kb_ + (32 * u + r) * VROW + (16 * s + 8 * hf) * 2);
            f32x16 x0, x1;
#pragma unroll
            for (int i = 0; i < 16; ++i) { x0[i] = 0.f; x1[i] = 0.f; }
#pragma unroll
            for (int s = 0; s < 4; ++s) { x0 = __builtin_amdgcn_mfma_f32_32x32x16_bf16(kf[0][s], qf[s], x0, 0, 0, 0); x1 = __builtin_amdgcn_mfma_f32_32x32x16_bf16(kf[1][s], qf[s], x1, 0, 0, 0); }
            const bool win = (kind == 0 && pi >= 4);
            bool lv[2][4];
#pragma unroll
            for (int g = 0; g < 4; ++g) { lv[0][g] = !win || hq == 0 || g == 3; lv[1][g] = !win || hq == 1 || g == 0; }
            if (win) {
                const int ridx = wrow - grow + 7;
                int csl = cs - 4 * hf, bl = 4 * hf - qc + 15;
                asm volatile("" : "+v"(csl), "+v"(bl));
                const LAS float* rp = rpbL + ridx * 31 + bl;
#pragma unroll
                for (int g = 0; g < 4; ++g) {
                    if (lv[0][g]) {
#pragma unroll
                        for (int jx = 0; jx < 4; ++jx) { const int i = 4 * g + jx, ci = jx + 8 * g; const bool valid = (unsigned)(ci - csl) < 16u; const float bias = rp[ci]; x0[i] = valid ? x0[i] + bias : -1e30f; }
                    }
                    if (lv[1][g]) {
#pragma unroll
                        for (int jx = 0; jx < 4; ++jx) { const int i = 4 * g + jx, ci = jx + 8 * g; const bool valid = (unsigned)(ci + 32 - csl) < 16u; const float bias = rp[ci + 32]; x1[i] = valid ? x1[i] + bias : -1e30f; }
                    }
                }
            }
            float mx = -1e30f;
#pragma unroll
            for (int g = 0; g < 4; ++g) {
                if (lv[0][g]) mx = fmaxf(fmaxf(mx, fmaxf(x0[4 * g], x0[4 * g + 1])), fmaxf(x0[4 * g + 2], x0[4 * g + 3]));
                if (lv[1][g]) mx = fmaxf(fmaxf(mx, fmaxf(x1[4 * g], x1[4 * g + 1])), fmaxf(x1[4 * g + 2], x1[4 * g + 3]));
            }
            mx = fmaxf(mx, __shfl_xor(mx, 32));
            const float mnew = fmaxf(mrun, mx);
            const float alpha = __builtin_amdgcn_exp2f(mrun - mnew);
            float psum = 0.f;
#pragma unroll
            for (int g = 0; g < 4; ++g) {
                if (lv[0][g]) {
#pragma unroll
                    for (int jx = 0; jx < 4; ++jx) { const int i = 4 * g + jx; x0[i] = __builtin_amdgcn_exp2f(x0[i] - mnew); psum += x0[i]; }
                } else {
#pragma unroll
                    for (int jx = 0; jx < 4; ++jx) x0[4 * g + jx] = 0.f;
                }
                if (lv[1][g]) {
#pragma unroll
                    for (int jx = 0; jx < 4; ++jx) { const int i = 4 * g + jx; x1[i] = __builtin_amdgcn_exp2f(x1[i] - mnew); psum += x1[i]; }
                } else {
#pragma unroll
                    for (int jx = 0; jx < 4; ++jx) x1[4 * g + jx] = 0.f;
                }
            }
            lrun = lrun * alpha + psum; mrun = mnew;
#pragma unroll
            for (int i = 0; i < 16; ++i) { o0[i] *= alpha; o1[i] *= alpha; }
            const int q4 = (lane & 15) >> 2, p4 = lane & 3, blk = (lane >> 4) & 1;
#pragma unroll
            for (int u = 0; u < 2; ++u) {
                const LAS unsigned char* vcur = vb_ + (32 * u + 4 * hf + q4) * VROW + (16 * blk + 4 * p4) * 2;
#pragma unroll
                for (int s2 = 0; s2 < 2; ++s2) {
                    if (lv[u][2 * s2] || lv[u][2 * s2 + 1]) {
                        s16x4 lo[2], hi[2];
#pragma unroll
                        for (int db = 0; db < 2; ++db) { lo[db] = tr_read(vcur + (16 * s2) * VROW + 64 * db); hi[db] = tr_read(vcur + (16 * s2 + 8) * VROW + 64 * db); }
                        u32x4 pw;
                        if (u == 0) { pw.x = pk2(x0[8 * s2 + 0], x0[8 * s2 + 1]); pw.y = pk2(x0[8 * s2 + 2], x0[8 * s2 + 3]); pw.z = pk2(x0[8 * s2 + 4], x0[8 * s2 + 5]); pw.w = pk2(x0[8 * s2 + 6], x0[8 * s2 + 7]); }
                        else        { pw.x = pk2(x1[8 * s2 + 0], x1[8 * s2 + 1]); pw.y = pk2(x1[8 * s2 + 2], x1[8 * s2 + 3]); pw.z = pk2(x1[8 * s2 + 4], x1[8 * s2 + 5]); pw.w = pk2(x1[8 * s2 + 6], x1[8 * s2 + 7]); }
                        const bf16x8 pb = __builtin_bit_cast(bf16x8, pw);
                        const bf16x8 va0 = __builtin_shufflevector(lo[0], hi[0], 0, 1, 2, 3, 4, 5, 6, 7);
                        const bf16x8 va1 = __builtin_shufflevector(lo[1], hi[1], 0, 1, 2, 3, 4, 5, 6, 7);
                        o0 = __builtin_amdgcn_mfma_f32_32x32x16_bf16(va0, pb, o0, 0, 0, 0);
                        o1 = __builtin_amdgcn_mfma_f32_32x32x16_bf16(va1, pb, o1, 0, 0, 0);
                    }
                }
            }
        }
        if (more) {
            LAS unsigned char* nb = sb + ((pi + 1) & 1) * STG;
            const int jn = (jj + 1) % 3;
            *(LAS u32x4*)(nb + ldst) = kR[jn]; *(LAS u32x4*)(nb + PBUF + ldst) = vR[jn];
        }
        __syncthreads();
        }
      }
    }
#undef ATT_LOAD
    const float ltot = lrun + __shfl_xor(lrun, 32);
    const float inv = 1.0f / ltot;
    bf16_t* zrow = Gb + (size_t)qtok * 1024 + h * 64;
    u32x2 z[2][4];
#pragma unroll
    for (int db = 0; db < 2; ++db)
#pragma unroll
        for (int g = 0; g < 4; ++g) z[db][g] = *(const u32x2*)(zrow + 32 * db + 8 * g + 4 * hf);
#pragma unroll
    for (int db = 0; db < 2; ++db)
#pragma unroll
        for (int g = 0; g < 4; ++g) {
            const int d0 = 32 * db + 8 * g + 4 * hf;
            float ov[4];
#pragma unroll
            for (int j = 0; j < 4; ++j) ov[j] = (db == 0 ? o0[4 * g + j] : o1[4 * g + j]) * inv;
            u32x2 w; w.x = pk2(ov[0] * bflo(z[db][g].x), ov[1] * bfhi(z[db][g].x)); w.y = pk2(ov[2] * bflo(z[db][g].y), ov[3] * bfhi(z[db][g].y));
            if (!dry) *(u32x2*)(zrow + d0) = w;
        }
}

DI void pool_tasks(const Args& A, int gt, int GT, int dry) {
    const bf16_t* UC = (const bf16_t*)(A.ws + WS_UC); bf16_t* ZC = (bf16_t*)(A.ws + WS_G) + 768;
    for (int task = gt; task < T * 32; task += GT) {
        const int g = __builtin_amdgcn_readfirstlane(task / (T * 8)), rem = task - g * (T * 8), t = rem >> 3, c0 = g * 64 + (rem & 7) * 8, half = 1 << g;
        int tb, pos, L;
        if (t < TP) { tb = t & ~255; pos = t & 255; L = 256; } else { const int ts = t - TP; tb = TP + (ts & ~2047); pos = ts & 2047; L = 2048; }
        const int lo = max(pos - half, 0), hi = min(pos + half, L);
        float sum[8] = {0.f, 0.f, 0.f, 0.f, 0.f, 0.f, 0.f, 0.f};
#pragma unroll
        for (int j = 0; j < 16; ++j) {
            if (j >= 2 * half) break;
            const int p = lo + j; const bool ok = p < hi;
            const u32x4 w = *(const u32x4*)(UC + (size_t)(tb + (ok ? p : pos)) * 256 + c0);
            if (ok) { sum[0] += bflo(w.x); sum[1] += bfhi(w.x); sum[2] += bflo(w.y); sum[3] += bfhi(w.y); sum[4] += bflo(w.z); sum[5] += bfhi(w.z); sum[6] += bflo(w.w); sum[7] += bfhi(w.w); }
        }
        const float inv = __builtin_amdgcn_rcpf((float)(hi - lo));
        const u32x4 sf = *(const u32x4*)(UC + (size_t)t * 256 + c0);
        const u32x4 z = *(const u32x4*)(ZC + (size_t)t * 1024 + c0);
        const float s[8] = {bflo(sf.x), bfhi(sf.x), bflo(sf.y), bfhi(sf.y), bflo(sf.z), bfhi(sf.z), bflo(sf.w), bfhi(sf.w)};
        const float zz[8] = {bflo(z.x), bfhi(z.x), bflo(z.y), bfhi(z.y), bflo(z.z), bfhi(z.z), bflo(z.w), bfhi(z.w)};
        float o[8];
#pragma unroll
        for (int i = 0; i < 8; ++i) o[i] = zz[i] * (sum[i] * inv - s[i]);
        if (!dry) *(u32x4*)(ZC + (size_t)t * 1024 + c0) = pk8(o);
    }
}

DI void phase_mix(const Args& A, int l, LAS unsigned char* lds, int dry, int parts, bool sw_here) {
    const int tid = otid(), lane = tid & 63, wid = __builtin_amdgcn_readfirstlane(tid >> 6);
    const int c = blockIdx.x, G = gridDim.x;
    if (parts & 1) {
        FourSched S{(const char*)(A.ws + WS_DS), (const char*)(A.ws + WS_DP), (const char*)(A.ws + WS_VTS), (const char*)(A.ws + WS_VTP), c, G};
        EpiFour E{(bf16_t*)(A.ws + WS_XH), (bf16_t*)(A.ws + WS_XH) + 8ull * 8192 * 256};
        pg8::gemm_phase<EpiFour, FourSched>(lds, 512, 512, 8, S, E);
    }
    if (parts & 2) {
    for (int i = tid; i < 8 * 465; i += blockDim.x) ((LAS float*)lds)[64 + i] = A.rpb[(size_t)l * 8 * 465 + i] * LOG2E;
    __syncthreads();
    if (G == 256) {
        { const int wt = c; const int b = wt >> 6, h = (wt >> 3) & 7, r4 = wt & 7; attn_wg(A, l, 0, b, h, r4, lds, wid, lane, tid, dry); }
        if (c >= 144) {
            { const int m = c - 144; const int b = m >> 3, h = m & 7; attn_wg(A, l, 1, b, h, 0, lds, wid, lane, tid, dry); }
            const int r4c = c & 7; const int idx = r4c == 0 ? ((c - 144) >> 3) : (r4c == 7 ? 14 + ((c - 151) >> 3) : 99);
            if (idx < 16) { const int m = 112 + idx; const int b = m >> 3, h = m & 7; attn_wg(A, l, 1, b, h, 0, lds, wid, lane, tid, dry); }
        }
    } else
    for (int wt = c; wt < 384; wt += G) {
        if (wt < 256) { const int b = wt >> 6, h = (wt >> 3) & 7, r4 = wt & 7; attn_wg(A, l, 0, b, h, r4, lds, wid, lane, tid, dry); }
        else { const int m = wt - 256; const int b = m >> 3, h = m & 7; attn_wg(A, l, 1, b, h, 0, lds, wid, lane, tid, dry); }
    }
    }
    if (parts & 4) {
        {
            const bf16_t* VTS = (const bf16_t*)(A.ws + WS_VTS); float* Y1K = (float*)(A.ws + WS_Y1K);
            const int gw = __builtin_amdgcn_readfirstlane((blockIdx.x * blockDim.x + tid) >> 6), GW = (gridDim.x * blockDim.x) >> 6;
            for (int task = gw; task < 1024; task += GW) {
                const int b = task >> 8, e = task & 255;
                const bf16_t* row = VTS + ((size_t)(b * 8 + (lane >> 4)) * 256 + e) * 512 + (lane & 15) * 32;
                float a = 0.f;
#pragma unroll
                for (int q = 0; q < 4; ++q) { const u32x4 w = *(const u32x4*)(row + q * 8);
                    a += (bflo(w.x) - bfhi(w.x)) + (bflo(w.y) - bfhi(w.y)) + (bflo(w.z) - bfhi(w.z)) + (bflo(w.w) - bfhi(w.w)); }
#pragma unroll
                for (int o = 32; o >= 1; o >>= 1) a += __shfl_xor(a, o);
                if (lane == 0 && !dry) Y1K[(task & ~255) + pcol(e)] = a * (1.0f / sqrtf(2048.0f * 64.0f));
            }
        }
        pool_tasks(A, blockIdx.x * blockDim.x + tid, gridDim.x * blockDim.x, dry);
        if (sw_here && !dry) { const int gw2 = __builtin_amdgcn_readfirstlane((blockIdx.x * blockDim.x + tid) >> 6); sw_tasks(A, gw2, (gridDim.x * blockDim.x) >> 6, lane); }
    }
    __syncthreads();
}

DI void phase_gb(const Args& A, int dry) {
    const int gt = blockIdx.x * blockDim.x + otid(), GT = gridDim.x * blockDim.x;
    const bf16_t* YS = (const bf16_t*)(A.ws + WS_XH); const bf16_t* YP = YS + 8ull * 8192 * 256; bf16_t* ZB = (bf16_t*)(A.ws + WS_G) + 512;
    for (int task = gt; task < T * 32; task += GT) {
        const int tt = task >> 5, c0 = (task & 31) * 8;
        const int t = tt < TS ? TP + tt : tt - TS;
        float s[8] = {0.f, 0.f, 0.f, 0.f, 0.f, 0.f, 0.f, 0.f};
        const u32x4 z = *(const u32x4*)(ZB + (size_t)t * 1024 + c0);
        if (t < TP) {
            const u32x4 w = *(const u32x4*)(YP + (size_t)t * 256 + c0);
            s[0] = bflo(w.x); s[1] = bfhi(w.x); s[2] = bflo(w.y); s[3] = bfhi(w.y); s[4] = bflo(w.z); s[5] = bfhi(w.z); s[6] = bflo(w.w); s[7] = bfhi(w.w);
        } else {
            const int ts = t - TP, k1 = ts & 2047;
            if (k1 == 1024) {
                const float* y = (const float*)(A.ws + WS_Y1K) + (ts >> 11) * 256 + c0;
                const f32x4 y0 = *(const f32x4*)y, y1 = *(const f32x4*)(y + 4);
                s[0] = y0[0]; s[1] = y0[1]; s[2] = y0[2]; s[3] = y0[3]; s[4] = y1[0]; s[5] = y1[1]; s[6] = y1[2]; s[7] = y1[3];
            } else {
                const int src = (ts & ~2047) + (k1 < 1024 ? k1 : 2048 - k1);
                const float sg = k1 < 1024 ? 1.0f : -1.0f;
                u32x4 w[8];
#pragma unroll
                for (int kc = 0; kc < 8; ++kc) w[kc] = *(const u32x4*)(YS + ((size_t)kc * 8192 + src) * 256 + c0);
#pragma unroll
                for (int kc = 0; kc < 8; ++kc) { const float f = kc < 4 ? 1.0f : sg;
                    s[0] += f * bflo(w[kc].x); s[1] += f * bfhi(w[kc].x); s[2] += f * bflo(w[kc].y); s[3] += f * bfhi(w[kc].y); s[4] += f * bflo(w[kc].z); s[5] += f * bfhi(w[kc].z); s[6] += f * bflo(w[kc].w); s[7] += f * bfhi(w[kc].w); }
            }
        }
        float o[8] = {s[0] * bflo(z.x), s[1] * bfhi(z.x), s[2] * bflo(z.y), s[3] * bfhi(z.y), s[4] * bflo(z.z), s[5] * bfhi(z.z), s[6] * bflo(z.w), s[7] * bfhi(z.w)};
        if (!dry) *(u32x4*)(ZB + (size_t)t * 1024 + c0) = pk8(o);
    }
}

struct TileSched {
    const char* Ab; const char* Bb; size_t tileA, tileB; int c, G;
    DI bool next(int i, Unit& u) const { const int f = i * G + c; if (f >= 192) return false; const int pm = f >> 2, pn = f & 3; u.a = Ab + pm * tileA; u.b = Bb + pn * tileB; u.k0 = 0; u.k1 = pm; u.k2 = pn; u.k3 = 0; return true; }
};
struct HookProj {
    static constexpr bool ENABLED = true;
    const bf16_t* SG;
    DI void operator()(f32x4 (&acc)[2][2][4][2], const Unit& u, int t, int wr, int wc, int fr, int fq) const {
        LAUNDER();
        const size_t GT_ = (size_t)48 * 4 * 65536;
        const bf16_t* sp = SG + (t == 8 ? (size_t)0 : GT_) + ((size_t)u.k1 * 4 + u.k2) * 65536 + (size_t)((wr * 4 + wc) * 16 * 64 + fq * 16 + fr) * 8;
#pragma unroll
        for (int ai = 0; ai < 2; ++ai) {
            u32x4 gn[8], gd[8];
#pragma unroll
            for (int q = 0; q < 8; ++q) { gn[q] = __builtin_nontemporal_load((const u32x4*)(sp + (size_t)((ai * 8 + q) * 64) * 8)); gd[q] = *(const u32x4*)(sp + GT_ + (size_t)((ai * 8 + q) * 64) * 8); }
#pragma unroll
            for (int m = 0; m < 4; ++m)
#pragma unroll
                for (int bj = 0; bj < 2; ++bj) {
                    const u32x4 a = gn[m * 2 + bj], d = gd[m * 2 + bj];
                    f32x4 v0 = acc[ai][bj][m][0], v1 = acc[ai][bj][m][1];
                    v0[0] *= bflo(a.x) * __builtin_amdgcn_rcpf(fmaxf(bflo(d.x), 1e-30f)); v0[1] *= bfhi(a.x) * __builtin_amdgcn_rcpf(fmaxf(bfhi(d.x), 1e-30f));
                    v0[2] *= bflo(a.y) * __builtin_amdgcn_rcpf(fmaxf(bflo(d.y), 1e-30f)); v0[3] *= bfhi(a.y) * __builtin_amdgcn_rcpf(fmaxf(bfhi(d.y), 1e-30f));
                    v1[0] *= bflo(a.z) * __builtin_amdgcn_rcpf(fmaxf(bflo(d.z), 1e-30f)); v1[1] *= bfhi(a.z) * __builtin_amdgcn_rcpf(fmaxf(bfhi(d.z), 1e-30f));
                    v1[2] *= bflo(a.w) * __builtin_amdgcn_rcpf(fmaxf(bflo(d.w), 1e-30f)); v1[3] *= bfhi(a.w) * __builtin_amdgcn_rcpf(fmaxf(bfhi(d.w), 1e-30f));
                    acc[ai][bj][m][0] = v0; acc[ai][bj][m][1] = v1;
                }
        }
    }
};
struct EpiProj {
    const bf16_t* SGc; bf16_t* MG;
    DI void operator()(const f32x4 (&acc)[2][2][4][2], const Unit& u, int wr, int wc, int fr, int fq) const {
        LAUNDER();
        const bf16_t* sp = SGc + ((size_t)u.k1 * 4 + u.k2) * 65536 + (size_t)((wr * 4 + wc) * 16 * 64 + fq * 16 + fr) * 8;
#pragma unroll
        for (int ai = 0; ai < 2; ++ai) {
            u32x4 gc[8];
#pragma unroll
            for (int q = 0; q < 8; ++q) gc[q] = __builtin_nontemporal_load((const u32x4*)(sp + (size_t)((ai * 8 + q) * 64) * 8));
#pragma unroll
            for (int m = 0; m < 4; ++m) {
                const int t = 256 * u.k1 + 128 * ai + 64 * wr + 16 * m + fr;
                bf16_t* rowp = MG + (size_t)t * 1024 + 256 * u.k2 + 32 * wc + 8 * fq;
#pragma unroll
                for (int bj = 0; bj < 2; ++bj) {
                    const u32x4 g = gc[m * 2 + bj];
                    const f32x4 v0 = acc[ai][bj][m][0], v1 = acc[ai][bj][m][1];
                    u32x2 w0; w0.x = pk2(v0[0] * bflo(g.x), v0[1] * bfhi(g.x)); w0.y = pk2(v0[2] * bflo(g.y), v0[3] * bfhi(g.y));
                    u32x2 w1; w1.x = pk2(v1[0] * bflo(g.z), v1[1] * bfhi(g.z)); w1.y = pk2(v1[2] * bflo(g.w), v1[3] * bfhi(g.w));
                    u32x4 w01; w01.x = w0.x; w01.y = w0.y; w01.z = w1.x; w01.w = w1.y; *(u32x4*)(rowp + 128 * bj) = w01;
                }
            }
        }
    }
};
struct EpiOut {
    const float* xp; const float* xs; float* out; const float* ng1; int l; const float* ada; int dry; bf16_t* XG; float* rss;
    DI void operator()(const f32x4 (&acc)[2][2][4][2], const Unit& u, int wr, int wc, int fr, int fq) const {
        LAUNDER();
        const int t0 = 256 * u.k1; const int j = cond_of(t0);
        const int cb = 256 * u.k2 + 32 * wc + 8 * fq;
        const float* gate = ada + (size_t)(l * 5 + j) * 3072 + 2048 + cb;
        f32x4 gv[2][2], gm[2][2];
#pragma unroll
        for (int bj = 0; bj < 2; ++bj)
#pragma unroll
            for (int n = 0; n < 2; ++n) {
                gv[bj][n] = *(const f32x4*)(gate + 128 * bj + 4 * n);
                gm[bj][n] = (f32x4){0.f, 0.f, 0.f, 0.f};
                if (XG) gm[bj][n] = *(const f32x4*)(ng1 + cb + 128 * bj + 4 * n) * (*(const f32x4*)(ada + (size_t)(5 + j) * 3072 + 1024 + cb + 128 * bj + 4 * n) + 1.0f);
            }
#pragma unroll
        for (int ai = 0; ai < 2; ++ai)
#pragma unroll
            for (int mh = 0; mh < 2; ++mh) {
                f32x4 xv[2][2][2];
#pragma unroll
                for (int mm = 0; mm < 2; ++mm) {
                    const int t = t0 + 128 * ai + 64 * wr + 16 * (2 * mh + mm) + fr;
                    const float* xr = (l == 0 ? (t < TP ? xp + (size_t)t * 1024 : xs + (size_t)(t - TP) * 1024) : out + (size_t)t * 1024) + cb;
#pragma unroll
                    for (int bj = 0; bj < 2; ++bj)
#pragma unroll
                        for (int n = 0; n < 2; ++n) xv[mm][bj][n] = *(const f32x4*)(xr + 128 * bj + 4 * n);
                }
#pragma unroll
                for (int mm = 0; mm < 2; ++mm) {
                    const int m = 2 * mh + mm;
                    const int t = t0 + 128 * ai + 64 * wr + 16 * m + fr;
                    float* orow = out + (size_t)t * 1024 + cb;
                    float ssq = 0.f;
#pragma unroll
                    for (int bj = 0; bj < 2; ++bj) {
                        const f32x4 xn0 = xv[mm][bj][0] + gv[bj][0] * acc[ai][bj][m][0], xn1 = xv[mm][bj][1] + gv[bj][1] * acc[ai][bj][m][1];
                        if (!dry) { *(f32x4*)(orow + 128 * bj) = xn0; *(f32x4*)(orow + 128 * bj + 4) = xn1; }
                        if (XG) {
                            const f32x4 y0 = xn0 * gm[bj][0], y1 = xn1 * gm[bj][1];
                            u32x4 w; w.x = pk2(y0[0], y0[1]); w.y = pk2(y0[2], y0[3]); w.z = pk2(y1[0], y1[1]); w.w = pk2(y1[2], y1[3]);
                            if (!dry) *(u32x4*)(XG + (size_t)t * 1024 + cb + 128 * bj) = w;
                            ssq += xn0[0] * xn0[0] + xn0[1] * xn0[1] + xn0[2] * xn0[2] + xn0[3] * xn0[3] + xn1[0] * xn1[0] + xn1[1] * xn1[1] + xn1[2] * xn1[2] + xn1[3] * xn1[3];
                        }
                    }
                    if (XG) {
                        ssq += __shfl_xor(ssq, 16); ssq += __shfl_xor(ssq, 32);
                        if (fq == 0 && !dry) atomicAdd(rss + t, ssq);
                    }
                }
            }
    }
};

__global__ void __launch_bounds__(512, 2) mk_fwd(Args A0) {
    const Args& A = A0;
    extern __shared__ __attribute__((aligned(16))) unsigned char lds_raw[];
    LAS unsigned char* lds = (LAS unsigned char*)lds_raw;
    cg::grid_group grid = cg::this_grid();
    const int lo = A.ph_lo, hi = A.ph_hi;
    if (threadIdx.x < 4) ((LAS unsigned*)(lds + LDS_RING))[threadIdx.x] = 0u;
    __syncthreads();
    XcdBarrier xbar = xcd_barrier_post((unsigned*)(A.ws + WS_BAR), (volatile LAS unsigned*)(lds + LDS_RING));
    if (hi > 1000) grid.sync();
    const int c = blockIdx.x, G = gridDim.x;
    const bool fuse1 = (lo == 0 && hi == 14);
#define IN(k) (lo <= (k) && (k) < hi)
#define SEAM(k) do { if (IN(k) && IN((k) + 1)) xcd_barrier(xbar); } while (0)
#if defined(PROBE_PHASE)
#define NREPS(k) (((k) == PROBE_PHASE) ? 1 + PROBE_REPS : 1)
#else
#define NREPS(k) 1
#endif
#if defined(PROBE_PARTS)
#define PARTS(dry) ((dry) ? PROBE_PARTS : 7)
#else
#define PARTS(dry) 7
#endif
#define PHASE(k, ...) do { if (IN(k)) { const int nreps_ = NREPS(k); for (int rep_ = 0; rep_ < nreps_; ++rep_) { const int dry = rep_ > 0; (void)dry; if (rep_ > 0) xcd_barrier(xbar); \
        KArgP ap_ = (KArgP)__builtin_amdgcn_kernarg_segment_ptr(); asm volatile("" : "+s"(ap_)); \
        const Args& A = *(const Args*)ap_;     \
        __VA_ARGS__ } } SEAM(k); } while (0)
#if defined(PROBE_A_REPS)
    for (int r = 0; r < PROBE_A_REPS; ++r) phase_a(A, fuse1, lds);
#endif
    PHASE(0, phase_a(A, fuse1, lds););
#if defined(PROBE_SYNCS)
    for (int r = 0; r < PROBE_SYNCS; ++r) xcd_barrier(xbar);
#endif
    PHASE(1, { phase_b(A, lds, fuse1); if (fuse1) phase_norm(A, 0, false); });
    for (int l = 0; l < 2; ++l) {
        const int p0 = 2 + 6 * l;
        if (!fuse1) PHASE(p0, phase_norm(A, l, true););
        PHASE(p0 + 1, {
            InSched S{(const char*)(A.ws + WS_XH), (const char*)(A.ws + WS_WIN + (size_t)l * WIN_L), c, G};
            EpiIn E{l, (l == 1 && fuse1) ? 1 : 0, A.ws, A.out + (size_t)T * 1024, A.q_g, A.k_g};
            pg8::gemm_phase<EpiIn, InSched>(lds, 1024, 1024, 16, S, E);
        });
        PHASE(p0 + 2, phase_mix(A, l, lds, dry, PARTS(dry), fuse1 && l == 0););
        PHASE(p0 + 3, phase_gb(A, dry););
        PHASE(p0 + 4, {
            const bf16_t* SG = (const bf16_t*)(A.ws + WS_SG);
            TileSched S{(const char*)(A.ws + WS_G), (const char*)(A.ws + WS_PT + (size_t)l * 1024 * 1024 * 2), TILE1K, TILE1K, c, G};
            EpiProj E{SG + 2 * (size_t)48 * 4 * 65536, (bf16_t*)(A.ws + WS_QB)};
            HookProj H{SG};
            pg8::gemm_phase<EpiProj, TileSched, HookProj>(lds, 1024, 1024, 16, S, E, H);
        });
        PHASE(p0 + 5, {
            TileSched S{(const char*)(A.ws + WS_QB), (const char*)(A.ws + WS_WO + (size_t)l * 1024 * 1024 * 2), TILE1K, TILE1K, c, G};
            EpiOut E{A.x_prompt, A.x_sample, A.out, A.norm_g + 1024, l, (const float*)(A.ws + WS_ADA), dry, (l == 0 && fuse1) ? (bf16_t*)(A.ws + WS_XH) : (bf16_t*)nullptr, (float*)(A.ws + WS_RSS)};
            pg8::gemm_phase<EpiOut, TileSched>(lds, 1024, 1024, 16, S, E);
        });
    }
#undef IN
#undef SEAM
}

extern "C" void kernel_launch(void* const* d_in, const int* in_sizes, int n_in, void* d_out, int out_size, void* d_ws, size_t ws_size, hipStream_t stream) {
    static int grid = 0;
    if (grid == 0) {
        if (ws_size < WS_END) { fprintf(stderr, "kernel_launch: workspace too small: %zu < %zu\n", ws_size, (size_t)WS_END); grid = -1; return; }
        int dev = 0, cus = 0, per_cu = 0;
        hipGetDevice(&dev);
        hipDeviceGetAttribute(&cus, hipDeviceAttributeMultiprocessorCount, dev);
        if (hipFuncSetAttribute((const void*)mk_fwd, hipFuncAttributeMaxDynamicSharedMemorySize, LDS_BYTES) != hipSuccess) { fprintf(stderr, "kernel_launch: hipFuncSetAttribute failed\n"); grid = -1; return; }
        hipOccupancyMaxActiveBlocksPerMultiprocessor(&per_cu, (const void*)mk_fwd, 512, LDS_BYTES);
        (void)hipGetLastError();
        if (per_cu < 1) per_cu = 1;
        grid = cus;
        if (grid <= 0) grid = 256;
    }
    if (grid < 0) return;
    Args a{};
    a.x_prompt = (const float*)d_in[0]; a.x_sample = (const float*)d_in[1]; a.cache_k = (const float*)d_in[2]; a.cache_v = (const float*)d_in[3];
    a.c = (const float*)d_in[4]; a.c_ctx = (const float*)d_in[5]; a.norm_g = (const float*)d_in[6]; a.w_ada = (const float*)d_in[7]; a.b_ada = (const float*)d_in[8];
    a.w_in = (const float*)d_in[9]; a.q_g = (const float*)d_in[10]; a.k_g = (const float*)d_in[11]; a.rpb = (const float*)d_in[12]; a.w_fnet = (const float*)d_in[13];
    a.w_pool = (const float*)d_in[14]; a.pool_scale = (const float*)d_in[15]; a.p_a = (const float*)d_in[16]; a.p_b = (const float*)d_in[17]; a.p_c = (const float*)d_in[18]; a.w_o = (const float*)d_in[19];
    a.out = (float*)d_out; a.ws = (unsigned char*)d_ws;
#if MK_SINGLE
    if (hipMemsetAsync((char*)d_ws + WS_BAR, 0, ZERO_BYTES, stream) != hipSuccess) { fprintf(stderr, "kernel_launch: memset of the barrier words failed\n"); return; }
    if (hipMemsetAsync((char*)d_ws + WS_ADA, 0, 2ull * 5 * 3072 * 4, stream) != hipSuccess) { fprintf(stderr, "kernel_launch: memset of ADA failed\n"); return; }
    a.ph_lo = 0; a.ph_hi = 14;
    void* args[] = {&a};
    hipError_t e = hipLaunchCooperativeKernel((const void*)mk_fwd, dim3(grid), dim3(512), args, LDS_BYTES, stream);
    if (e != hipSuccess) fprintf(stderr, "cooperative launch failed: %s (grid %d)\n", hipGetErrorString(e), grid);
#else
    for (int p = 0; p < 14; ++p) {
        a.ph_lo = p; a.ph_hi = p + 1;
        hipLaunchKernelGGL(mk_fwd, dim3(grid), dim3(512), LDS_BYTES, stream, a);
    }
#endif
}
```
